# Optimizing an MI355X kernel written in HIP

```python
import math
import jax, jax.numpy as jnp
from jax import lax
import numpy as np

D_MODEL = 1024
BATCH = 32
SEQ = 2048
DEPTH = 1

HEAD_DIM = 64
MOBA_HEADS = 8
SB_HEADS = 8
MOBA_WIDTH = MOBA_HEADS * HEAD_DIM
SB_WIDTH = SB_HEADS * HEAD_DIM
N_BRANCHES = 2
GATE_WIDTH = N_BRANCHES * D_MODEL
IN_WIDTH = 3 * MOBA_WIDTH + 3 * SB_WIDTH + GATE_WIDTH
MOBA_BLOCK = 256
MOBA_TOPK = 3
Q_BLOCK = 128
D_FF = 4 * D_MODEL
ROPE_THETA = 10000.0
RMS_EPS = 1e-6
NEG = -1e30

kernel_name = "hybrid_moba_stickbreaking_gated_block"


def _rmsnorm(x, g):
    x32 = x.astype(jnp.float32)
    ms = jnp.mean(x32 * x32, axis=-1, keepdims=True)
    return (x32 * lax.rsqrt(ms + RMS_EPS) * g.astype(jnp.float32)).astype(x.dtype)


def _rope_tables(seq):
    half = HEAD_DIM // 2
    inv_freq = ROPE_THETA ** (-jnp.arange(half, dtype=jnp.float32) * 2.0 / HEAD_DIM)
    ang = jnp.arange(seq, dtype=jnp.float32)[:, None] * inv_freq[None, :]
    ang = jnp.concatenate([ang, ang], axis=-1)
    return jnp.cos(ang), jnp.sin(ang)


def _rope(t, cos, sin):
    t32 = t.astype(jnp.float32)
    half = HEAD_DIM // 2
    rot = jnp.concatenate([-t32[..., half:], t32[..., :half]], axis=-1)
    return (t32 * cos + rot * sin).astype(t.dtype)


def _to_heads(t, n_heads):
    b, s, _ = t.shape
    return t.reshape(b, s, n_heads, HEAD_DIM).transpose(0, 2, 1, 3)


def _from_heads(t):
    b, h, s, d = t.shape
    return t.transpose(0, 2, 1, 3).reshape(b, s, h * d)


def _moba_attention(q, k, v):
    b, h, s, d = q.shape
    nb = -(-s // MOBA_BLOCK)
    pad = nb * MOBA_BLOCK - s
    kp = jnp.pad(k, ((0, 0), (0, 0), (0, pad), (0, 0)))
    vp = jnp.pad(v, ((0, 0), (0, 0), (0, pad), (0, 0)))
    kblk = kp.reshape(b, h, nb, MOBA_BLOCK, d)
    vblk = vp.reshape(b, h, nb, MOBA_BLOCK, d)
    kmean = jnp.mean(kblk.astype(jnp.float32), axis=3)
    topk = min(MOBA_TOPK, nb)
    n_chunks = s // Q_BLOCK
    scale = 1.0 / math.sqrt(d)
    h_idx = jnp.arange(h)[:, None, None]

    def one_seq(args):
        qs, kbs, vbs, kms = args

        def one_chunk(c):
            start = c * Q_BLOCK
            qc = lax.dynamic_slice_in_dim(qs, start, Q_BLOCK, axis=1).astype(jnp.float32)
            qpos = start + jnp.arange(Q_BLOCK)
            own = start // MOBA_BLOCK
            gate = jnp.einsum('hqd,hnd->hqn', qc, kms)
            past = jnp.arange(nb) < own
            gate = jnp.where(past[None, None, :], gate, NEG)
            _, gidx = lax.top_k(gate, topk)
            valid = gidx < own
            ksel = kbs[h_idx, gidx]
            vsel = vbs[h_idx, gidx]
            s_sel = jnp.einsum('hqd,hqtkd->hqtk', qc, ksel.astype(jnp.float32)) * scale
            s_sel = jnp.where(valid[..., None], s_sel, NEG).reshape(h, Q_BLOCK, topk * MOBA_BLOCK)
            kown = lax.dynamic_index_in_dim(kbs, own, axis=1, keepdims=False).astype(jnp.float32)
            vown = lax.dynamic_index_in_dim(vbs, own, axis=1, keepdims=False).astype(jnp.float32)
            s_own = jnp.einsum('hqd,hkd->hqk', qc, kown) * scale
            kpos = own * MOBA_BLOCK + jnp.arange(MOBA_BLOCK)
            s_own = jnp.where(kpos[None, None, :] <= qpos[None, :, None], s_own, NEG)
            p = jax.nn.softmax(jnp.concatenate([s_sel, s_own], axis=-1), axis=-1)
            p_sel = p[..., :topk * MOBA_BLOCK].reshape(h, Q_BLOCK, topk, MOBA_BLOCK)
            p_own = p[..., topk * MOBA_BLOCK:]
            o = (jnp.einsum('hqtk,hqtkd->hqd', p_sel, vsel.astype(jnp.float32))
                 + jnp.einsum('hqk,hkd->hqd', p_own, vown))
            return o.astype(q.dtype)

        out = lax.map(one_chunk, jnp.arange(n_chunks))
        return out.transpose(1, 0, 2, 3).reshape(h, s, d)

    return lax.map(one_seq, (q, kblk, vblk, kmean))


def _stick_breaking_attention(q, k, v):
    b, h, s, d = q.shape
    scale = 1.0 / math.sqrt(d)
    outs = []
    for c in range(s // Q_BLOCK):
        start, end = c * Q_BLOCK, (c + 1) * Q_BLOCK
        qc = q[:, :, start:end].astype(jnp.float32)
        kc = k[:, :, :end].astype(jnp.float32)
        vc = v[:, :, :end].astype(jnp.float32)
        z = jnp.einsum('bhqd,bhkd->bhqk', qc, kc) * scale
        qpos = start + jnp.arange(Q_BLOCK)
        kpos = jnp.arange(end)
        mask = kpos[None, :] < qpos[:, None]
        log_1mb = jnp.where(mask, jax.nn.log_sigmoid(-z), 0.0)
        suffix = lax.cumsum(log_1mb, axis=3, reverse=True) - log_1mb
        a = jnp.where(mask, jnp.exp(jax.nn.log_sigmoid(z) + suffix), 0.0)
        outs.append(jnp.einsum('bhqk,bhkd->bhqd', a, vc).astype(q.dtype))
    return jnp.concatenate(outs, axis=2)


def setup_inputs(seed: int = 0) -> dict:
    key = jax.random.key(seed)
    ks = jax.random.split(key, 12)
    f32 = jnp.float32
    def nrm(k, shape, fan_in):
        return jax.random.normal(k, shape, f32) * (fan_in ** -0.5)
    def gain(k):
        return jnp.ones((DEPTH, D_MODEL), f32) + 0.05 * jax.random.normal(k, (DEPTH, D_MODEL), f32)
    return {
        "x": jax.random.normal(ks[0], (BATCH, SEQ, D_MODEL), f32),
        "g_pre_mix": gain(ks[1]),
        "w_in": nrm(ks[2], (DEPTH, D_MODEL, IN_WIDTH), D_MODEL),
        "b_gate": 0.02 * jax.random.normal(ks[3], (DEPTH, GATE_WIDTH), f32),
        "w_up_moba": nrm(ks[4], (DEPTH, MOBA_WIDTH, D_MODEL), MOBA_WIDTH),
        "w_up_sb": nrm(ks[5], (DEPTH, SB_WIDTH, D_MODEL), SB_WIDTH),
        "w_out": nrm(ks[6], (DEPTH, D_MODEL, D_MODEL), D_MODEL),
        "g_post_mix": gain(ks[7]),
        "g_pre_mlp": gain(ks[8]),
        "w_mlp_in": nrm(ks[9], (DEPTH, D_MODEL, D_FF), D_MODEL),
        "w_mlp_out": nrm(ks[10], (DEPTH, D_FF, D_MODEL), D_FF),
        "g_post_mlp": gain(ks[11]),
    }


def reference(x, g_pre_mix, w_in, b_gate, w_up_moba, w_up_sb, w_out, g_post_mix,
              g_pre_mlp, w_mlp_in, w_mlp_out, g_post_mlp):
    b, s, _ = x.shape
    cos, sin = _rope_tables(s)
    cos, sin = cos.astype(x.dtype), sin.astype(x.dtype)
    split_at = list(np.cumsum([MOBA_WIDTH] * 3 + [SB_WIDTH] * 3))
    for l in range(DEPTH):
        hn = _rmsnorm(x, g_pre_mix[l])
        proj = jnp.einsum('bsd,de->bse', hn, w_in[l])
        qa, ka, va, qb, kb, vb, gates = jnp.split(proj, split_at, axis=-1)
        qa = _rope(_to_heads(qa, MOBA_HEADS), cos, sin)
        ka = _rope(_to_heads(ka, MOBA_HEADS), cos, sin)
        va = _to_heads(va, MOBA_HEADS)
        qb, kb, vb = (_to_heads(t, SB_HEADS) for t in (qb, kb, vb))
        y_moba = _from_heads(_moba_attention(qa, ka, va))
        y_sb = _from_heads(_stick_breaking_attention(qb, kb, vb))
        y_moba = jnp.einsum('bse,ed->bsd', y_moba, w_up_moba[l])
        y_sb = jnp.einsum('bse,ed->bsd', y_sb, w_up_sb[l])
        g = jax.nn.sigmoid((gates + b_gate[l]).astype(jnp.float32)).astype(x.dtype)
        g_moba, g_sb = g[..., :D_MODEL], g[..., D_MODEL:]
        mixed = g_moba * y_moba + g_sb * y_sb
        mix_out = jnp.einsum('bsd,de->bse', mixed, w_out[l])
        x = x + _rmsnorm(mix_out, g_post_mix[l])
        hn = _rmsnorm(x, g_pre_mlp[l])
        u = jnp.einsum('bsd,df->bsf', hn, w_mlp_in[l])
        u = jnp.square(jax.nn.relu(u))
        m = jnp.einsum('bsf,fd->bsd', u, w_mlp_out[l])
        x = x + _rmsnorm(m, g_post_mlp[l])
    return x
```

```cpp
#include <hip/hip_runtime.h>
#include <hip/hip_cooperative_groups.h>
#include <cstdio>
#include <cstdint>
#include <cmath>
namespace cg = cooperative_groups;

#define LAS __attribute__((address_space(3)))
typedef unsigned short bf16_t;
typedef short bf16x8 __attribute__((ext_vector_type(8)));
typedef short s16x4 __attribute__((ext_vector_type(4)));
typedef float f32x4 __attribute__((ext_vector_type(4)));
typedef float f32x16 __attribute__((ext_vector_type(16)));
typedef unsigned u32x4 __attribute__((ext_vector_type(4)));
typedef unsigned u32x2 __attribute__((ext_vector_type(2)));
typedef float f32x2_t __attribute__((ext_vector_type(2)));
typedef __bf16 bf16x2_t __attribute__((ext_vector_type(2)));

constexpr int M = 65536, D = 1024, NIN = 5120, FF = 4096, SEQ = 2048, NBATCH = 32;
constexpr float EPS = 1e-6f;
constexpr float QS = 0.125f * 1.4426950408889634f;
constexpr size_t MiB = 1u << 20;
constexpr size_t WS_ROPE = 1 * MiB;
constexpr size_t WS_KMEAN = WS_ROPE + 512 * 1024;
constexpr size_t WS_WIN = 2 * MiB, WS_WUP = 12 * MiB, WS_WOUT = 14 * MiB, WS_WMI = 16 * MiB, WS_WMO = 24 * MiB;
constexpr size_t WS_XN = 32 * MiB;
constexpr size_t WS_Y = 160 * MiB;
constexpr size_t WS_PROJ = 288 * MiB;
constexpr size_t WS_END = 928 * MiB;
constexpr int LDS_BYTES = 135168;

__device__ __forceinline__ unsigned cvtpk(float lo, float hi) { f32x2_t v = {lo, hi}; bf16x2_t b = __builtin_convertvector(v, bf16x2_t); return __builtin_bit_cast(unsigned, b); }
__device__ __forceinline__ float bf_lo(unsigned u) { return __uint_as_float(u << 16); }
__device__ __forceinline__ float bf_hi(unsigned u) { return __uint_as_float(u & 0xffff0000u); }

namespace pg8 {
constexpr int BM = 256, BK = 64, HALF = 128, HTB = HALF * BK * 2, STAGE_BYTES = 8 * HTB, NXCD = 8, WGM = 8;
__host__ __device__ __forceinline__ int lds_byte(int r, int c) { const int st = (r >> 4) * 2 + (c >> 5), rr = r & 15, cc = c & 31, ob = rr * 64 + cc * 2; return st * 1024 + (ob ^ (((ob >> 9) & 1) << 5)); }
__host__ __device__ __forceinline__ void stage_rc(int b, int& R, int& C) { const int st = b / 1024, sb = b % 1024, swz = sb ^ (((sb >> 9) & 1) << 5); R = (st >> 1) * 16 + swz / 64; C = (st & 1) * 32 + (swz % 64) / 2; }
__host__ __device__ __forceinline__ int perm32(int rho) { const int n = rho >> 4, i = rho & 15; return 8 * (i >> 2) + 4 * n + (i & 3); }

struct Unit { int pm, pn, z; };
struct Gemm { const bf16_t* A; const bf16_t* Bt; int lda, ldb, K; size_t zA, zB; };

struct StaticOrder {
    int nM, nN, nwg, G, c;
    __device__ void init(int M_, int N_, int G_, int c_) { nM = M_ / BM; nN = N_ / BM; nwg = nM * nN; G = G_; c = c_; }
    __device__ bool next(int i, Unit& u) const {
        const long L = (long)i * G + c; if (L >= nwg) return false;
        int wgid = (int)L; { const int q = nwg / NXCD, r = nwg % NXCD, xcd = wgid % NXCD, off = wgid / NXCD; wgid = (xcd < r ? xcd * (q + 1) : r * (q + 1) + (xcd - r) * q) + off; }
        const int nig = WGM * nN, gid = wgid / nig, fm = gid * WGM, gsz = (nM - fm) < WGM ? (nM - fm) : WGM;
        u.pm = fm + ((wgid % nig) % gsz); u.pn = (wgid % nig) / gsz; u.z = 0; return true;
    }
};
struct DualOrder {
    StaticOrder S;
    __device__ bool next(int i, Unit& u) const { const bool ok = S.next(i >> 1, u); u.z = i & 1; return ok; }
};

template <int ACT  > struct EpiBf16 {
    bf16_t* O; int ldc;
    __device__ __forceinline__ void operator()(const f32x4 (&acc)[2][2][4][2], const Unit& u, int wr, int wc, int fr, int fq) const {
        const int row0 = u.pm * BM + wr * 64 + fr, col0 = u.pn * BM + wc * 32 + 8 * fq;
#pragma unroll
        for (int ai = 0; ai < 2; ++ai)
#pragma unroll
            for (int m = 0; m < 4; ++m) { bf16_t* rowp = O + (size_t)(row0 + ai * HALF + m * 16) * ldc + col0;
#pragma unroll
                for (int bj = 0; bj < 2; ++bj) { f32x4 v0 = acc[ai][bj][m][0], v1 = acc[ai][bj][m][1];
                    if (ACT == 1) {
#pragma unroll
                        for (int j = 0; j < 4; ++j) { const float a = fmaxf(v0[j], 0.f), b = fmaxf(v1[j], 0.f); v0[j] = a * a; v1[j] = b * b; } }
                    u32x4 w; w.x = cvtpk(v0[0], v0[1]); w.y = cvtpk(v0[2], v0[3]); w.z = cvtpk(v1[0], v1[1]); w.w = cvtpk(v1[2], v1[3]);
                    *(u32x4*)(rowp + bj * HALF) = w; } }
    }
};
struct EpiIn {
    bf16_t* O; const float* bias; const float* rope;
    __device__ __forceinline__ void operator()(const f32x4 (&acc)[2][2][4][2], const Unit& u, int wr, int wc, int fr, int fq) const {
        const int row0 = u.pm * BM + wr * 64 + fr, col0 = u.pn * BM + wc * 32 + 8 * fq;
        const int mode = u.pn < 4 ? 1 : (u.pn >= 12 ? 2 : 0);
        f32x4 bv[2][2];
#pragma unroll
        for (int bj = 0; bj < 2; ++bj)
#pragma unroll
            for (int n = 0; n < 2; ++n) bv[bj][n] = (mode == 2) ? *(const f32x4*)(bias + (col0 - 3072) + bj * HALF + 4 * n) : (f32x4){0.f, 0.f, 0.f, 0.f};
#pragma unroll
        for (int ai = 0; ai < 2; ++ai)
#pragma unroll
            for (int m = 0; m < 4; ++m) { const int row = row0 + ai * HALF + m * 16; bf16_t* rowp = O + (size_t)row * NIN + col0; const int pos = row & (SEQ - 1);
#pragma unroll
                for (int bj = 0; bj < 2; ++bj) { f32x4 v0 = acc[ai][bj][m][0], v1 = acc[ai][bj][m][1];
                    if (mode == 1) {
                        const int i0 = ((col0 + bj * HALF) & 63) >> 1;
                        const f32x4 cs = *(const f32x4*)(rope + pos * 32 + i0), sn = *(const f32x4*)(rope + SEQ * 32 + pos * 32 + i0);
                        f32x4 a, b;
                        a[0] = v0[0] * cs[0] - v0[1] * sn[0]; a[1] = v0[1] * cs[0] + v0[0] * sn[0];
                        a[2] = v0[2] * cs[1] - v0[3] * sn[1]; a[3] = v0[3] * cs[1] + v0[2] * sn[1];
                        b[0] = v1[0] * cs[2] - v1[1] * sn[2]; b[1] = v1[1] * cs[2] + v1[0] * sn[2];
                        b[2] = v1[2] * cs[3] - v1[3] * sn[3]; b[3] = v1[3] * cs[3] + v1[2] * sn[3];
                        v0 = a; v1 = b;
                    } else if (mode == 2) {
                        v0 = v0 + bv[bj][0]; v1 = v1 + bv[bj][1];
#pragma unroll
                        for (int j = 0; j < 4; ++j) { v0[j] = 1.f / (1.f + __expf(-v0[j])); v1[j] = 1.f / (1.f + __expf(-v1[j])); }
                    }
                    u32x4 w; w.x = cvtpk(v0[0], v0[1]); w.y = cvtpk(v0[2], v0[3]); w.z = cvtpk(v1[0], v1[1]); w.w = cvtpk(v1[2], v1[3]);
                    *(u32x4*)(rowp + bj * HALF) = w; } }
    }
};
struct EpiUp {
    bf16_t* O; float* part; const bf16_t* proj;
    __device__ __forceinline__ void operator()(const f32x4 (&acc)[2][2][4][2], const Unit& u, int wr, int wc, int fr, int fq) const {
        const int row0 = u.pm * BM + wr * 64 + fr, col0 = u.pn * BM + wc * 32 + 8 * fq;
        if (u.z == 1) asm volatile("s_waitcnt vmcnt(0)" ::: "memory");
#pragma unroll
        for (int ai = 0; ai < 2; ++ai)
#pragma unroll
            for (int m = 0; m < 4; ++m) { const int row = row0 + ai * HALF + m * 16;
#pragma unroll
                for (int bj = 0; bj < 2; ++bj) { const int col = col0 + bj * HALF;
                    const u32x4 gw = *(const u32x4*)(proj + (size_t)row * NIN + 3072 + u.z * 1024 + col);
                    f32x4 v0 = acc[ai][bj][m][0], v1 = acc[ai][bj][m][1];
                    v0[0] *= bf_lo(gw.x); v0[1] *= bf_hi(gw.x); v0[2] *= bf_lo(gw.y); v0[3] *= bf_hi(gw.y);
                    v1[0] *= bf_lo(gw.z); v1[1] *= bf_hi(gw.z); v1[2] *= bf_lo(gw.w); v1[3] *= bf_hi(gw.w);
                    float* pp = part + (size_t)row * D + col;
                    if (u.z == 0) { *(f32x4*)pp = v0; *(f32x4*)(pp + 4) = v1; }
                    else { v0 = v0 + *(const f32x4*)pp; v1 = v1 + *(const f32x4*)(pp + 4);
                        u32x4 w; w.x = cvtpk(v0[0], v0[1]); w.y = cvtpk(v0[2], v0[3]); w.z = cvtpk(v1[0], v1[1]); w.w = cvtpk(v1[2], v1[3]);
                        *(u32x4*)(O + (size_t)row * D + col) = w; } } }
    }
};

template <class Epi, class Sched, bool ALIGN_EPI>
__device__ __forceinline__ void gemm_phase(LAS unsigned char* lds, const Gemm g, const Sched& S, const Epi& E) {
    const int tid = threadIdx.x, wid = __builtin_amdgcn_readfirstlane(tid >> 6), lane = tid & 63, wr = wid >> 2, wc = wid & 3, fr = lane & 15, fq = lane >> 4;
    const int K = g.K, nt = K / BK;
    unsigned voffA[2], voffB[2];
#pragma unroll
    for (int i = 0; i < 2; ++i) { int R, C; stage_rc(tid * 16 + i * 8192, R, C); const int Rb = (R & ~31) + perm32(R & 31);
        voffA[i] = (unsigned)(R * g.lda + C) * 2u; voffB[i] = (unsigned)(Rb * g.ldb + C) * 2u; }
    const size_t kstep = (size_t)(BK * 2);
    const size_t hstepA = (size_t)HALF * g.lda * 2, hstepB = (size_t)HALF * g.ldb * 2;
    const size_t tstepA = 2 * hstepA, tstepB = 2 * hstepB;
    const unsigned ldsw = (unsigned)wid * 1024u;
    const int aoff = lds_byte(wr * 64 + fr, fq * 8), boff = lds_byte(wc * 32 + fr, fq * 8);
#define PG8_SA(b, h) (((b) * 2 + (h)) * HTB)
#define PG8_SB(b, h) ((4 + (b) * 2 + (h)) * HTB)
#define PG8_STAGE(bufoff, gbase, voff) do { _Pragma("unroll") for (int _i = 0; _i < 2; ++_i) \
        __builtin_amdgcn_global_load_lds((const unsigned*)((const char*)(gbase) + (voff)[_i]), (LAS unsigned*)(lds + (bufoff) + ldsw + _i * 8192), 16, 0, 0); } while (0)
#define PG8_LDA(dst, b, h) do { _Pragma("unroll") for (int m = 0; m < 4; ++m) _Pragma("unroll") for (int k = 0; k < 2; ++k) dst[m][k] = *(const LAS bf16x8*)(lds + PG8_SA(b, h) + aoff + m * 2048 + k * 1024); } while (0)
#define PG8_LDB(dst, b, h) do { _Pragma("unroll") for (int n = 0; n < 2; ++n) _Pragma("unroll") for (int k = 0; k < 2; ++k) dst[n][k] = *(const LAS bf16x8*)(lds + PG8_SB(b, h) + boff + n * 2048 + k * 1024); } while (0)
#define PG8_MMA(ai, bj, At, Bt) do { __builtin_amdgcn_s_setprio(1); _Pragma("unroll") for (int m = 0; m < 4; ++m) _Pragma("unroll") for (int n = 0; n < 2; ++n) _Pragma("unroll") for (int k = 0; k < 2; ++k) \
        acc[ai][bj][m][n] = __builtin_amdgcn_mfma_f32_16x16x32_bf16(Bt[n][k], At[m][k], acc[ai][bj][m][n], 0, 0, 0); __builtin_amdgcn_s_setprio(0); } while (0)
#define PG8_WAIT_V(n) asm volatile("s_waitcnt vmcnt(" #n ")" ::: "memory")
#define PG8_WAIT_L(n) asm volatile("s_waitcnt lgkmcnt(" #n ")" ::: "memory")
#define PG8_BAR __builtin_amdgcn_s_barrier()
#define PG8_SCHED __builtin_amdgcn_sched_barrier(0)
    Unit cur, nxt; int ui = 0;
    if (!S.next(0, cur)) return;
    f32x4 acc[2][2][4][2];
#pragma unroll
    for (int a = 0; a < 2; ++a)
#pragma unroll
        for (int b = 0; b < 2; ++b)
#pragma unroll
            for (int m = 0; m < 4; ++m)
#pragma unroll
                for (int n = 0; n < 2; ++n) acc[a][b][m][n] = (f32x4){0.f, 0.f, 0.f, 0.f};
    bf16x8 At[4][2], B0[2][2], B1[2][2];
    const char* cA = (const char*)g.A + (size_t)cur.pm * tstepA + (size_t)cur.z * g.zA; const char* cB = (const char*)g.Bt + (size_t)cur.pn * tstepB + (size_t)cur.z * g.zB;
    PG8_STAGE(PG8_SB(0, 0), cB, voffB); PG8_STAGE(PG8_SB(0, 1), cB + hstepB, voffB); PG8_STAGE(PG8_SA(0, 0), cA, voffA); PG8_STAGE(PG8_SA(0, 1), cA + hstepA, voffA);
    if (wr == 1) PG8_BAR;
    PG8_WAIT_V(2); PG8_BAR;
    PG8_STAGE(PG8_SB(1, 0), cB + kstep, voffB); PG8_STAGE(PG8_SA(1, 0), cA + kstep, voffA); PG8_STAGE(PG8_SB(1, 1), cB + hstepB + kstep, voffB);
    PG8_WAIT_V(6); PG8_BAR;
    for (;;) {
        const bool has_next = S.next(ui + 1, nxt);
        const char* nA = has_next ? (const char*)g.A + (size_t)nxt.pm * tstepA + (size_t)nxt.z * g.zA : cA; const char* nB = has_next ? (const char*)g.Bt + (size_t)nxt.pn * tstepB + (size_t)nxt.z * g.zB : cB;
        for (int t = 0; t < nt; t += 2) {
            const bool last = (t == nt - 2);
            const char* a1 = cA + (size_t)(t + 1) * kstep;
            const char* a2 = last ? nA : cA + (size_t)(t + 2) * kstep; const char* b2 = last ? nB : cB + (size_t)(t + 2) * kstep;
            const char* a3 = a2 + kstep; const char* b3 = b2 + kstep;
            PG8_LDB(B0, 0, 0); PG8_LDB(B1, 0, 1); PG8_SCHED; PG8_LDA(At, 0, 0); PG8_STAGE(PG8_SA(1, 1), a1 + hstepA, voffA);
            PG8_WAIT_V(8); PG8_WAIT_L(0); PG8_BAR; PG8_MMA(0, 0, At, B0); PG8_MMA(0, 1, At, B1); PG8_BAR; PG8_SCHED;
            PG8_LDA(At, 0, 1); PG8_STAGE(PG8_SB(0, 0), b2, voffB); PG8_STAGE(PG8_SB(0, 1), b2 + hstepB, voffB); PG8_STAGE(PG8_SA(0, 0), a2, voffA);
            PG8_WAIT_V(8); PG8_WAIT_L(0); PG8_BAR; PG8_MMA(1, 0, At, B0); PG8_MMA(1, 1, At, B1); PG8_BAR; PG8_SCHED;
            PG8_LDB(B0, 1, 0); PG8_LDB(B1, 1, 1); PG8_SCHED; PG8_LDA(At, 1, 0); PG8_STAGE(PG8_SA(0, 1), a2 + hstepA, voffA);
            PG8_WAIT_V(8); PG8_WAIT_L(0); PG8_BAR; PG8_MMA(0, 0, At, B0); PG8_MMA(0, 1, At, B1); PG8_BAR; PG8_SCHED;
            PG8_LDA(At, 1, 1); PG8_STAGE(PG8_SB(1, 0), b3, voffB); PG8_STAGE(PG8_SB(1, 1), b3 + hstepB, voffB); PG8_STAGE(PG8_SA(1, 0), a3, voffA);
            PG8_WAIT_V(8); PG8_WAIT_L(0); PG8_BAR; PG8_MMA(1, 0, At, B0); PG8_MMA(1, 1, At, B1); PG8_BAR; PG8_SCHED;
        }
        if constexpr (ALIGN_EPI) { if (wr == 0) PG8_BAR; }
        E(acc, cur, wr, wc, fr, fq);
        if (!has_next) break;
#pragma unroll
        for (int a = 0; a < 2; ++a)
#pragma unroll
            for (int b = 0; b < 2; ++b)
#pragma unroll
                for (int m = 0; m < 4; ++m)
#pragma unroll
                    for (int n = 0; n < 2; ++n) acc[a][b][m][n] = (f32x4){0.f, 0.f, 0.f, 0.f};
        cur = nxt; cA = nA; cB = nB; ++ui;
        if constexpr (ALIGN_EPI) { if (wr == 1) PG8_BAR; }
    }
    PG8_WAIT_V(0);
    if constexpr (!ALIGN_EPI) { if (wr == 0) PG8_BAR; }
    PG8_BAR;
#undef PG8_SA
#undef PG8_SB
#undef PG8_STAGE
#undef PG8_LDA
#undef PG8_LDB
#undef PG8_MMA
#undef PG8_WAIT_V
#undef PG8_WAIT_L
#undef PG8_BAR
#undef PG8_SCHED
}
}

namespace att {
__device__ __forceinline__ int crow(int r, int hi) { return (r & 3) + 8 * (r >> 2) + 4 * hi; }
struct KVRegs { u32x4 k, v; };
__device__ __forceinline__ void kv_load(KVRegs& r, const bf16_t* Kp, const bf16_t* Vp, int tile, int tid) {
    const int row = tile * 64 + (tid >> 3), ch = tid & 7;
    r.k = *(const u32x4*)(Kp + (size_t)row * NIN + ch * 8);
    r.v = *(const u32x4*)(Vp + (size_t)row * NIN + ch * 8);
}
__device__ __forceinline__ void kv_store(const KVRegs& r, LAS unsigned char* kbuf, LAS unsigned char* vbuf, int tid) {
    const int row = tid >> 3, ch = tid & 7;
    *(LAS u32x4*)(kbuf + ch * 1024 + row * 16) = r.k;
    *(LAS u32x4*)(vbuf + ((ch >> 2) * 4 + (row >> 4)) * 1024 + (row & 15) * 64 + (ch & 3) * 16) = r.v;
}
__device__ __forceinline__ void qkt(f32x16& p0, f32x16& p1, LAS const unsigned char* kbuf, const bf16x8* qr, int r32, int hi) {
    LAS const unsigned char* kb = kbuf + hi * 1024 + r32 * 16;
    p0 = f32x16{}; p1 = f32x16{};
#pragma unroll
    for (int d0 = 0; d0 < 4; ++d0) {
        const bf16x8 b0 = *(LAS const bf16x8*)(kb + d0 * 2048);
        const bf16x8 b1 = *(LAS const bf16x8*)(kb + d0 * 2048 + 512);
        p0 = __builtin_amdgcn_mfma_f32_32x32x16_bf16(b0, qr[d0], p0, 0, 0, 0);
        p1 = __builtin_amdgcn_mfma_f32_32x32x16_bf16(b1, qr[d0], p1, 0, 0, 0);
    }
}
typedef short v4i16_t __attribute__((ext_vector_type(4)));
__device__ __forceinline__ s16x4 vtr(LAS const unsigned char* p) { return __builtin_bit_cast(s16x4, __builtin_amdgcn_ds_read_tr16_b64_v4i16((LAS v4i16_t*)p)); }
__device__ __forceinline__ void pv(f32x16* o, LAS const unsigned char* vbuf, const f32x16& p0, const f32x16& p1, int lane, int hi) {
    LAS const unsigned char* vp = vbuf + ((lane >> 4) & 1) * 32 + (lane & 3) * 8 + (4 * hi + ((lane & 15) >> 2)) * 64;
    u32x4 pw[4];
    pw[0] = (u32x4){cvtpk(p0[0], p0[1]), cvtpk(p0[2], p0[3]), cvtpk(p0[4], p0[5]), cvtpk(p0[6], p0[7])};
    pw[1] = (u32x4){cvtpk(p0[8], p0[9]), cvtpk(p0[10], p0[11]), cvtpk(p0[12], p0[13]), cvtpk(p0[14], p0[15])};
    pw[2] = (u32x4){cvtpk(p1[0], p1[1]), cvtpk(p1[2], p1[3]), cvtpk(p1[4], p1[5]), cvtpk(p1[6], p1[7])};
    pw[3] = (u32x4){cvtpk(p1[8], p1[9]), cvtpk(p1[10], p1[11]), cvtpk(p1[12], p1[13]), cvtpk(p1[14], p1[15])};
#pragma unroll
    for (int d0 = 0; d0 < 2; ++d0)
#pragma unroll
        for (int ks = 0; ks < 4; ++ks) {
            const s16x4 lo = vtr(vp + d0 * 4096 + ks * 1024), hh = vtr(vp + d0 * 4096 + ks * 1024 + 512);
            const bf16x8 vf = (bf16x8){lo[0], lo[1], lo[2], lo[3], hh[0], hh[1], hh[2], hh[3]};
            o[d0] = __builtin_amdgcn_mfma_f32_32x32x16_bf16(__builtin_bit_cast(bf16x8, pw[ks]), vf, o[d0], 0, 0, 0);
        }
}
constexpr int LDS_KV = 0, LDS_WS = 32768;

__device__ __forceinline__ void moba_unit(int b, int h, int qb, const bf16_t* proj, const float* kmean, bf16_t* Y, LAS unsigned char* lds) {
    const int tid = threadIdx.x, lane = tid & 63, r32 = lane & 31, hi = lane >> 5; const int wid = __builtin_amdgcn_readfirstlane(tid >> 6);
    const size_t rowbase = (size_t)b * SEQ; const int q0 = qb * 256, qrel = wid * 32 + r32;
    const bf16_t* Qrow = proj + (rowbase + q0 + qrel) * NIN + h * 64;
    const bf16_t* Kp = proj + rowbase * NIN + 512 + h * 64; const bf16_t* Vp = proj + rowbase * NIN + 1024 + h * 64;
    LAS float* wsf = (LAS float*)(lds + LDS_WS) + wid * 32;
    bf16x8 qr[4];
#pragma unroll
    for (int d0 = 0; d0 < 4; ++d0) qr[d0] = *(const bf16x8*)(Qrow + d0 * 16 + hi * 8);
    unsigned sel = 0;
    if (qb > 0) {
        float qf[32];
#pragma unroll
        for (int c = 0; c < 4; ++c) { const u32x4 w = *(const u32x4*)(Qrow + hi * 32 + c * 8);
            qf[c * 8 + 0] = bf_lo(w.x); qf[c * 8 + 1] = bf_hi(w.x); qf[c * 8 + 2] = bf_lo(w.y); qf[c * 8 + 3] = bf_hi(w.y);
            qf[c * 8 + 4] = bf_lo(w.z); qf[c * 8 + 5] = bf_hi(w.z); qf[c * 8 + 6] = bf_lo(w.w); qf[c * 8 + 7] = bf_hi(w.w); }
        float g[7];
#pragma unroll
        for (int n = 0; n < 7; ++n) { g[n] = -INFINITY;
            if (n < qb) { const float* km = kmean + ((size_t)(b * 8 + n) * 512 + h * 64 + 32 * hi); float s = 0.f;
#pragma unroll
                for (int j = 0; j < 32; j += 4) { const f32x4 kv = *(const f32x4*)(km + j); s += qf[j] * kv[0] + qf[j + 1] * kv[1] + qf[j + 2] * kv[2] + qf[j + 3] * kv[3]; }
                s += __shfl_xor(s, 32); g[n] = s; } }
#pragma unroll
        for (int n = 0; n < 7; ++n) { int cnt = 0;
#pragma unroll
            for (int n2 = 0; n2 < 7; ++n2) if (n2 != n) cnt += (g[n2] > g[n] || (g[n2] == g[n] && n2 < n)) ? 1 : 0;
            if (n < qb && cnt < 3) sel |= 1u << n; }
    }
    const int NT = 4 * qb + 4;
    KVRegs kv; kv_load(kv, Kp, Vp, 4 * qb, tid);
    float mrow = -INFINITY, lsum = 0.f; f32x16 o[2]; o[0] = f32x16{}; o[1] = f32x16{};
    for (int idx = 0; idx < NT; ++idx) {
        LAS unsigned char* kbuf = lds + LDS_KV + (idx & 1) * 16384; LAS unsigned char* vbuf = kbuf + 8192;
        kv_store(kv, kbuf, vbuf, tid);
        __syncthreads();
        if (idx + 1 < NT) kv_load(kv, Kp, Vp, (idx + 1 < 4) ? 4 * qb + idx + 1 : idx + 1 - 4, tid);
        const int kt = idx < 4 ? 4 * qb + idx : idx - 4;
        const bool mysel = idx < 4 ? true : (((sel >> (kt >> 2)) & 1u) != 0u);
        const bool active = idx < 4 ? (64 * idx <= 32 * wid + 31) : (__any(mysel ? 1 : 0) != 0);
        if (active) {
            f32x16 p0, p1; qkt(p0, p1, kbuf, qr, r32, hi);
            if (idx < 4) { const int kb = 64 * idx + 4 * hi;
#pragma unroll
                for (int r = 0; r < 16; ++r) { const int kvp = kb + (r & 3) + 8 * (r >> 2); if (kvp > qrel) p0[r] = -INFINITY; if (kvp + 32 > qrel) p1[r] = -INFINITY; } }
            else if (!mysel) {
#pragma unroll
                for (int r = 0; r < 16; ++r) { p0[r] = -INFINITY; p1[r] = -INFINITY; } }
            float rm = fmaxf(p0[0], p1[0]);
#pragma unroll
            for (int r = 1; r < 16; ++r) rm = fmaxf(rm, fmaxf(p0[r], p1[r]));
            rm = fmaxf(rm, __shfl_xor(rm, 32));
            const float mn = fmaxf(mrow, rm);
            if (__any(mn > mrow ? 1 : 0)) {
                const float f = __builtin_amdgcn_exp2f(mrow - mn);
                lsum *= f;
                if (hi == 0) wsf[r32] = f;
                asm volatile("s_waitcnt lgkmcnt(0)" ::: "memory");
#pragma unroll
                for (int r = 0; r < 16; ++r) { const float fr_ = wsf[crow(r, hi)]; o[0][r] *= fr_; o[1][r] *= fr_; }
                asm volatile("s_waitcnt lgkmcnt(0)" ::: "memory");
            }
            mrow = mn;
            float s = 0.f;
#pragma unroll
            for (int r = 0; r < 16; ++r) { p0[r] = __builtin_amdgcn_exp2f(p0[r] - mn); p1[r] = __builtin_amdgcn_exp2f(p1[r] - mn); s += p0[r] + p1[r]; }
            lsum += s;
            pv(o, vbuf, p0, p1, lane, hi);
        }
    }
    lsum += __shfl_xor(lsum, 32);
    if (hi == 0) wsf[r32] = 1.f / lsum;
    asm volatile("s_waitcnt lgkmcnt(0)" ::: "memory");
    bf16_t* Yw = Y + (rowbase + q0 + wid * 32) * D + h * 64 + r32;
#pragma unroll
    for (int r = 0; r < 16; ++r) { const int orow = crow(r, hi); const float il = wsf[orow];
        const unsigned w0 = cvtpk(o[0][r] * il, o[1][r] * il);
        Yw[(size_t)orow * D] = (bf16_t)(w0 & 0xffffu); Yw[(size_t)orow * D + 32] = (bf16_t)(w0 >> 16); }
    __syncthreads();
}

__device__ __forceinline__ void sb_unit(int b, int h, int qb, const bf16_t* proj, bf16_t* Y, LAS unsigned char* lds) {
    const int tid = threadIdx.x, lane = tid & 63, r32 = lane & 31, hi = lane >> 5; const int wid = __builtin_amdgcn_readfirstlane(tid >> 6);
    const size_t rowbase = (size_t)b * SEQ; const int w0 = qb * 256 + wid * 32, qpos = w0 + r32;
    const bf16_t* Qrow = proj + (rowbase + qpos) * NIN + 1536 + h * 64;
    const bf16_t* Kp = proj + rowbase * NIN + 2048 + h * 64; const bf16_t* Vp = proj + rowbase * NIN + 2560 + h * 64;
    bf16x8 qr[4];
#pragma unroll
    for (int d0 = 0; d0 < 4; ++d0) qr[d0] = *(const bf16x8*)(Qrow + d0 * 16 + hi * 8);
    float carry = 0.f; f32x16 o[2]; o[0] = f32x16{}; o[1] = f32x16{};
    int t = 4 * qb + 3, it = 0; bool wdone = false;
    KVRegs kv; kv_load(kv, Kp, Vp, t, tid);
    for (;;) {
        LAS unsigned char* kbuf = lds + LDS_KV + (it & 1) * 16384; LAS unsigned char* vbuf = kbuf + 8192;
        kv_store(kv, kbuf, vbuf, tid);
        if (__syncthreads_and(wdone ? 1 : 0)) break;
        if (t > 0) kv_load(kv, Kp, Vp, t - 1, tid);
        if (!wdone && 64 * t < w0 + 31) {
            f32x16 z0, z1; qkt(z0, z1, kbuf, qr, r32, hi);
            f32x16 L0, L1;
            const int kb = 64 * t + 4 * hi;
#pragma unroll
            for (int r = 0; r < 16; ++r) { const int key = kb + (r & 3) + 8 * (r >> 2);
                { const float z = z0[r]; const float sp = fmaxf(z, 0.f) + __builtin_amdgcn_logf(1.f + __builtin_amdgcn_exp2f(-fabsf(z))); const bool v = key < qpos; L0[r] = v ? -sp : 0.f; z0[r] = v ? z - sp : -INFINITY; }
                { const float z = z1[r]; const float sp = fmaxf(z, 0.f) + __builtin_amdgcn_logf(1.f + __builtin_amdgcn_exp2f(-fabsf(z))); const bool v = key + 32 < qpos; L1[r] = v ? -sp : 0.f; z1[r] = v ? z - sp : -INFINITY; } }
            float gs[8], tot[8];
#pragma unroll
            for (int g = 0; g < 4; ++g) { gs[g] = (L0[4 * g] + L0[4 * g + 1]) + (L0[4 * g + 2] + L0[4 * g + 3]); gs[4 + g] = (L1[4 * g] + L1[4 * g + 1]) + (L1[4 * g + 2] + L1[4 * g + 3]); }
#pragma unroll
            for (int g = 0; g < 8; ++g) tot[g] = gs[g] + __shfl_xor(gs[g], 32);
            float run = carry;
#pragma unroll
            for (int g = 7; g >= 0; --g) {
                const float e = run + (hi == 0 ? (tot[g] - gs[g]) : 0.f);
                run += tot[g];
                if (g >= 4) { const int q4 = 4 * (g - 4); const float l3 = L1[q4 + 3], l2 = L1[q4 + 2], l1 = L1[q4 + 1];
                    z1[q4 + 3] = __builtin_amdgcn_exp2f(z1[q4 + 3] + e); z1[q4 + 2] = __builtin_amdgcn_exp2f(z1[q4 + 2] + (e + l3));
                    z1[q4 + 1] = __builtin_amdgcn_exp2f(z1[q4 + 1] + (e + l3 + l2)); z1[q4] = __builtin_amdgcn_exp2f(z1[q4] + (e + l3 + l2 + l1)); }
                else { const int q4 = 4 * g; const float l3 = L0[q4 + 3], l2 = L0[q4 + 2], l1 = L0[q4 + 1];
                    z0[q4 + 3] = __builtin_amdgcn_exp2f(z0[q4 + 3] + e); z0[q4 + 2] = __builtin_amdgcn_exp2f(z0[q4 + 2] + (e + l3));
                    z0[q4 + 1] = __builtin_amdgcn_exp2f(z0[q4 + 1] + (e + l3 + l2)); z0[q4] = __builtin_amdgcn_exp2f(z0[q4] + (e + l3 + l2 + l1)); }
            }
            carry = run;
            pv(o, vbuf, z0, z1, lane, hi);
            wdone = __all(carry < -150.f ? 1 : 0) != 0;
        }
        if (t == 0) break;
        --t; ++it;
    }
    bf16_t* Yw = Y + (rowbase + w0) * D + 512 + h * 64 + r32;
#pragma unroll
    for (int r = 0; r < 16; ++r) { const int orow = crow(r, hi);
        const unsigned wv = cvtpk(o[0][r], o[1][r]);
        Yw[(size_t)orow * D] = (bf16_t)(wv & 0xffffu); Yw[(size_t)orow * D + 32] = (bf16_t)(wv >> 16); }
    __syncthreads();
}
}

__device__ __forceinline__ float wave_sum(float v) {
#pragma unroll
    for (int o = 1; o < 64; o <<= 1) v += __shfl_xor(v, o);
    return v;
}
__device__ __forceinline__ void transpose_item(const float* W, int K, int N, bf16_t* WT, int mode, LAS float* scr, int item, int lane) {
    const int nblk = N / 32, kb = item / nblk, nb = item % nblk, k0 = 64 * kb, n0 = 32 * nb;
#pragma unroll 8
    for (int i = 0; i < 32; ++i) { const int kk = 2 * i + (lane >> 5); scr[kk * 33 + (lane & 31)] = W[(size_t)(k0 + kk) * N + n0 + (lane & 31)]; }
    asm volatile("s_waitcnt lgkmcnt(0)" ::: "memory");
    const int c = lane & 7;
#pragma unroll
    for (int j = 0; j < 4; ++j) { const int n = (lane >> 3) + 8 * j; const int ng = n0 + n; int drow = ng; float sc = 1.f;
        if (mode == 1) { if (ng < 1024) { const int l = ng & 63; drow = (ng & ~63) | ((l & 31) << 1) | (l >> 5); } if (ng < 512 || (ng >= 1536 && ng < 2048)) sc = QS; }
        const LAS float* s = scr + (8 * c) * 33 + n;
        u32x4 o; o.x = cvtpk(s[0 * 33] * sc, s[1 * 33] * sc); o.y = cvtpk(s[2 * 33] * sc, s[3 * 33] * sc); o.z = cvtpk(s[4 * 33] * sc, s[5 * 33] * sc); o.w = cvtpk(s[6 * 33] * sc, s[7 * 33] * sc);
        *(u32x4*)(WT + (size_t)drow * K + k0 + 8 * c) = o; }
    asm volatile("s_waitcnt lgkmcnt(0)" ::: "memory");
}
__device__ __forceinline__ void rms_row_to_bf16(const float* xrow, const float* g, bf16_t* orow, int lane) {
    const f32x4* xr = (const f32x4*)xrow + lane; const f32x4* gr = (const f32x4*)g + lane;
    f32x4 v[4]; float s = 0.f;
#pragma unroll
    for (int j = 0; j < 4; ++j) { v[j] = xr[64 * j]; s += (v[j].x * v[j].x + v[j].y * v[j].y) + (v[j].z * v[j].z + v[j].w * v[j].w); }
    const float rs = 1.f / sqrtf(wave_sum(s) * (1.f / D) + EPS);
    u32x2* o8 = (u32x2*)orow + lane;
#pragma unroll
    for (int j = 0; j < 4; ++j) { const f32x4 gg = gr[64 * j]; u32x2 w; w.x = cvtpk(v[j].x * rs * gg.x, v[j].y * rs * gg.y); w.y = cvtpk(v[j].z * rs * gg.z, v[j].w * rs * gg.w); o8[64 * j] = w; }
}

struct Args { const float* in[12]; float* out; unsigned char* ws; };

__global__ void __launch_bounds__(512, 2) fwd(Args a) {
    extern __shared__ __attribute__((aligned(16))) unsigned char lds_raw[];
    LAS unsigned char* lds = (LAS unsigned char*)lds_raw;
    cg::grid_group grid = cg::this_grid();
    const int tid = threadIdx.x, lane = tid & 63, wave = __builtin_amdgcn_readfirstlane(tid >> 6);
    const int G = gridDim.x, bx = blockIdx.x;
    const float* x = a.in[0]; const float* g_pre_mix = a.in[1]; const float* w_in = a.in[2]; const float* b_gate = a.in[3];
    const float* w_up_moba = a.in[4]; const float* w_up_sb = a.in[5]; const float* w_out = a.in[6]; const float* g_post_mix = a.in[7];
    const float* g_pre_mlp = a.in[8]; const float* w_mlp_in = a.in[9]; const float* w_mlp_out = a.in[10]; const float* g_post_mlp = a.in[11];
    unsigned char* ws = a.ws; float* out = a.out;
    float* rope = (float*)(ws + WS_ROPE); float* kmean = (float*)(ws + WS_KMEAN);
    bf16_t* Wt_in = (bf16_t*)(ws + WS_WIN); bf16_t* Wt_up = (bf16_t*)(ws + WS_WUP); bf16_t* Wt_out = (bf16_t*)(ws + WS_WOUT);
    bf16_t* Wt_mi = (bf16_t*)(ws + WS_WMI); bf16_t* Wt_mo = (bf16_t*)(ws + WS_WMO);
    bf16_t* XN = (bf16_t*)(ws + WS_XN); bf16_t* Y = (bf16_t*)(ws + WS_Y); bf16_t* proj = (bf16_t*)(ws + WS_PROJ); bf16_t* HB = (bf16_t*)(ws + WS_PROJ);
    const int gw = bx * 8 + wave, NGW = G * 8;

    {
        LAS float* scr = (LAS float*)(lds + wave * 16384);
        constexpr int I_IN = (D / 64) * (NIN / 32), I_UP = (512 / 64) * (D / 32), I_OUT = (D / 64) * (D / 32), I_MI = (D / 64) * (FF / 32), I_MO = (FF / 64) * (D / 32);
        constexpr int NITEMS = I_IN + 2 * I_UP + I_OUT + I_MI + I_MO;
        for (int it = gw; it < NITEMS; it += NGW) {
            int r = it;
            if (r < I_IN) { transpose_item(w_in, D, NIN, Wt_in, 1, scr, r, lane); continue; } r -= I_IN;
            if (r < I_UP) { transpose_item(w_up_moba, 512, D, Wt_up, 0, scr, r, lane); continue; } r -= I_UP;
            if (r < I_UP) { transpose_item(w_up_sb, 512, D, Wt_up + (size_t)D * 512, 0, scr, r, lane); continue; } r -= I_UP;
            if (r < I_OUT) { transpose_item(w_out, D, D, Wt_out, 0, scr, r, lane); continue; } r -= I_OUT;
            if (r < I_MI) { transpose_item(w_mlp_in, D, FF, Wt_mi, 0, scr, r, lane); continue; } r -= I_MI;
            transpose_item(w_mlp_out, FF, D, Wt_mo, 0, scr, r, lane);
        }
        for (int i = bx * 512 + tid; i < SEQ * 32; i += G * 512) { const int pos = i >> 5, fi = i & 31;
            const float inv = powf(10000.0f, -(float)fi * 2.0f / 64.0f); const float ang = (float)pos * inv;
            rope[i] = cosf(ang); rope[SEQ * 32 + i] = sinf(ang); }
        for (int m = gw; m < M; m += NGW) rms_row_to_bf16(x + (size_t)m * D, g_pre_mix, XN + (size_t)m * D, lane);
    }
    grid.sync();

    {
        pg8::Gemm g{XN, Wt_in, D, D, D, 0, 0}; pg8::StaticOrder S; S.init(M, NIN, G, bx);
        pg8::EpiIn E{proj, b_gate, rope};
        pg8::gemm_phase<pg8::EpiIn, pg8::StaticOrder, true>(lds, g, S, E);
    }
    grid.sync();

    for (int u = bx; u < NBATCH * 8; u += G) {
        const int cp = tid & 255, half = tid >> 8;
        const bf16_t* src = proj + ((size_t)u * 256 + half * 128) * NIN + 512 + cp * 2;
        float s0 = 0.f, s1 = 0.f;
#pragma unroll 8
        for (int r = 0; r < 128; ++r) { const unsigned w = *(const unsigned*)(src + (size_t)r * NIN); s0 += bf_lo(w); s1 += bf_hi(w); }
        LAS float* red = (LAS float*)lds;
        if (half == 1) { red[cp * 2] = s0; red[cp * 2 + 1] = s1; }
        __syncthreads();
        if (half == 0) { kmean[(size_t)u * 512 + cp * 2] = (s0 + red[cp * 2]) * (1.f / 256.f); kmean[(size_t)u * 512 + cp * 2 + 1] = (s1 + red[cp * 2 + 1]) * (1.f / 256.f); }
        __syncthreads();
    }
    grid.sync();

    for (int bh = bx; bh < NBATCH * 8; bh += G) {
        const int b = bh >> 3, h = bh & 7;
        for (int qb = 7; qb >= 0; --qb) att::moba_unit(b, h, qb, proj, kmean, Y, lds);
        for (int qb = 7; qb >= 0; --qb) att::sb_unit(b, h, qb, proj, Y, lds);
    }
    grid.sync();

    {
        pg8::Gemm g{Y, Wt_up, D, 512, 512, (size_t)512 * 2, (size_t)D * 512 * 2}; pg8::DualOrder S; S.S.init(M, D, G, bx);
        pg8::EpiUp E{XN, out, proj};
        pg8::gemm_phase<pg8::EpiUp, pg8::DualOrder, true>(lds, g, S, E);
    }
    grid.sync();

    {
        pg8::Gemm g{XN, Wt_out, D, D, D, 0, 0}; pg8::StaticOrder S; S.init(M, D, G, bx);
        pg8::EpiBf16<0> E{Y, D};
        pg8::gemm_phase<pg8::EpiBf16<0>, pg8::StaticOrder, true>(lds, g, S, E);
    }
    grid.sync();

    for (int m = gw; m < M; m += NGW) {
        const f32x4* xr = (const f32x4*)(x + (size_t)m * D) + lane; const u32x2* mr = (const u32x2*)(Y + (size_t)m * D) + lane;
        f32x4 v[4], xv[4]; float s = 0.f;
#pragma unroll
        for (int j = 0; j < 4; ++j) { const u32x2 w = mr[64 * j]; v[j] = (f32x4){bf_lo(w.x), bf_hi(w.x), bf_lo(w.y), bf_hi(w.y)}; xv[j] = xr[64 * j];
            s += (v[j].x * v[j].x + v[j].y * v[j].y) + (v[j].z * v[j].z + v[j].w * v[j].w); }
        const float rs = 1.f / sqrtf(wave_sum(s) * (1.f / D) + EPS);
        float s2 = 0.f; f32x4* orow = (f32x4*)(out + (size_t)m * D) + lane;
#pragma unroll
        for (int j = 0; j < 4; ++j) { const f32x4 gg = ((const f32x4*)g_post_mix)[lane + 64 * j]; xv[j] = xv[j] + v[j] * rs * gg; orow[64 * j] = xv[j];
            s2 += (xv[j].x * xv[j].x + xv[j].y * xv[j].y) + (xv[j].z * xv[j].z + xv[j].w * xv[j].w); }
        const float rs2 = 1.f / sqrtf(wave_sum(s2) * (1.f / D) + EPS);
        u32x2* o8 = (u32x2*)(XN + (size_t)m * D) + lane;
#pragma unroll
        for (int j = 0; j < 4; ++j) { const f32x4 gg = ((const f32x4*)g_pre_mlp)[lane + 64 * j]; u32x2 w; w.x = cvtpk(xv[j].x * rs2 * gg.x, xv[j].y * rs2 * gg.y); w.y = cvtpk(xv[j].z * rs2 * gg.z, xv[j].w * rs2 * gg.w); o8[64 * j] = w; }
    }
    grid.sync();

    {
        pg8::Gemm g{XN, Wt_mi, D, D, D, 0, 0}; pg8::StaticOrder S; S.init(M, FF, G, bx);
        pg8::EpiBf16<1> E{HB, FF};
        pg8::gemm_phase<pg8::EpiBf16<1>, pg8::StaticOrder, true>(lds, g, S, E);
    }
    grid.sync();

    {
        pg8::Gemm g{HB, Wt_mo, FF, FF, FF, 0, 0}; pg8::StaticOrder S; S.init(M, D, G, bx);
        pg8::EpiBf16<0> E{Y, D};
        pg8::gemm_phase<pg8::EpiBf16<0>, pg8::StaticOrder, true>(lds, g, S, E);
    }
    grid.sync();

    for (int m = gw; m < M; m += NGW) {
        const u32x2* mr = (const u32x2*)(Y + (size_t)m * D) + lane; f32x4* orow = (f32x4*)(out + (size_t)m * D) + lane;
        f32x4 v[4], xv[4]; float s = 0.f;
#pragma unroll
        for (int j = 0; j < 4; ++j) { const u32x2 w = mr[64 * j]; v[j] = (f32x4){bf_lo(w.x), bf_hi(w.x), bf_lo(w.y), bf_hi(w.y)}; xv[j] = orow[64 * j];
            s += (v[j].x * v[j].x + v[j].y * v[j].y) + (v[j].z * v[j].z + v[j].w * v[j].w); }
        const float rs = 1.f / sqrtf(wave_sum(s) * (1.f / D) + EPS);
#pragma unroll
        for (int j = 0; j < 4; ++j) { const f32x4 gg = ((const f32x4*)g_post_mlp)[lane + 64 * j]; orow[64 * j] = xv[j] + v[j] * rs * gg; }
    }
}

extern "C" void kernel_launch(void* const* d_in, const int* in_sizes, int n_in, void* d_out, int out_size, void* d_ws, size_t ws_size, hipStream_t stream) {
    static int grid = 0;
    if (grid == 0) {
        if (n_in != 12 || in_sizes[0] != M * D || out_size != M * D || ws_size < WS_END) { fprintf(stderr, "kernel_launch: unexpected shapes (n_in %d, ws %zu)\n", n_in, ws_size); grid = -1; return; }
        int dev = 0, cus = 0, per_cu = 0;
        (void)hipGetDevice(&dev); (void)hipDeviceGetAttribute(&cus, hipDeviceAttributeMultiprocessorCount, dev);
        (void)hipFuncSetAttribute((const void*)fwd, hipFuncAttributeMaxDynamicSharedMemorySize, LDS_BYTES);
        (void)hipOccupancyMaxActiveBlocksPerMultiprocessor(&per_cu, (const void*)fwd, 512, LDS_BYTES);
        if (per_cu < 1) { fprintf(stderr, "kernel_launch: occupancy query says %d blocks per CU\n", per_cu); per_cu = 1; }
        (void)hipGetLastError();
        grid = cus;
    }
    if (grid < 0) return;
    Args a{};
    for (int i = 0; i < 12; ++i) a.in[i] = (const float*)d_in[i];
    a.out = (float*)d_out; a.ws = (unsigned char*)d_ws;
    void* args[] = {&a};
    hipError_t e = hipLaunchCooperativeKernel((const void*)fwd, dim3(grid), dim3(512), args, LDS_BYTES, stream);
    if (e != hipSuccess) fprintf(stderr, "cooperative launch failed: %s (grid %d)\n", hipGetErrorString(e), grid);
}
```

```cpp
#include <hip/hip_runtime.h>
#include <hip/hip_cooperative_groups.h>
#include <cstdio>
#include <cstdint>
#include <cmath>
namespace cg = cooperative_groups;

#define LAS __attribute__((address_space(3)))
typedef unsigned short bf16_t;
typedef short bf16x8 __attribute__((ext_vector_type(8)));
typedef short s16x4 __attribute__((ext_vector_type(4)));
typedef float f32x4 __attribute__((ext_vector_type(4)));
typedef float f32x16 __attribute__((ext_vector_type(16)));
typedef unsigned u32x4 __attribute__((ext_vector_type(4)));
typedef unsigned u32x2 __attribute__((ext_vector_type(2)));
typedef float f32x2_t __attribute__((ext_vector_type(2)));
typedef __bf16 bf16x2_t __attribute__((ext_vector_type(2)));

constexpr int M = 65536, D = 1024, NIN = 5120, FF = 4096, SEQ = 2048, NBATCH = 32;
constexpr float EPS = 1e-6f;
constexpr float QS = 0.125f * 1.4426950408889634f;
constexpr size_t MiB = 1u << 20;
constexpr size_t WS_ROPE = 1 * MiB;
constexpr size_t WS_KMEAN = WS_ROPE + 512 * 1024;
constexpr size_t WS_WIN = 2 * MiB, WS_WUP = 12 * MiB, WS_WOUT = 14 * MiB, WS_WMI = 16 * MiB, WS_WMO = 24 * MiB;
constexpr size_t WS_XN = 32 * MiB;
constexpr size_t WS_Y = 160 * MiB;
constexpr size_t WS_PROJ = 288 * MiB;
constexpr size_t WS_END = 928 * MiB;
constexpr int LDS_BYTES = 135168;

__device__ __forceinline__ unsigned cvtpk(float lo, float hi) { f32x2_t v = {lo, hi}; bf16x2_t b = __builtin_convertvector(v, bf16x2_t); return __builtin_bit_cast(unsigned, b); }
__device__ __forceinline__ float bf_lo(unsigned u) { return __uint_as_float(u << 16); }
__device__ __forceinline__ float bf_hi(unsigned u) { return __uint_as_float(u & 0xffff0000u); }

namespace pg8 {
constexpr int BM = 256, BK = 64, HALF = 128, HTB = HALF * BK * 2, STAGE_BYTES = 8 * HTB, NXCD = 8, WGM = 8;
__host__ __device__ __forceinline__ int lds_byte(int r, int c) { const int st = (r >> 4) * 2 + (c >> 5), rr = r & 15, cc = c & 31, ob = rr * 64 + cc * 2; return st * 1024 + (ob ^ (((ob >> 9) & 1) << 5)); }
__host__ __device__ __forceinline__ void stage_rc(int b, int& R, int& C) { const int st = b / 1024, sb = b % 1024, swz = sb ^ (((sb >> 9) & 1) << 5); R = (st >> 1) * 16 + swz / 64; C = (st & 1) * 32 + (swz % 64) / 2; }
__host__ __device__ __forceinline__ int perm32(int rho) { const int n = rho >> 4, i = rho & 15; return 8 * (i >> 2) + 4 * n + (i & 3); }

struct Unit { int pm, pn, z; };
struct Gemm { const bf16_t* A; const bf16_t* Bt; int lda, ldb, K; size_t zA, zB; };

struct StaticOrder {
    int nM, nN, nwg, G, c;
    __device__ void init(int M_, int N_, int G_, int c_) { nM = M_ / BM; nN = N_ / BM; nwg = nM * nN; G = G_; c = c_; }
    __device__ bool next(int i, Unit& u) const {
        const long L = (long)i * G + c; if (L >= nwg) return false;
        int wgid = (int)L; { const int q = nwg / NXCD, r = nwg % NXCD, xcd = wgid % NXCD, off = wgid / NXCD; wgid = (xcd < r ? xcd * (q + 1) : r * (q + 1) + (xcd - r) * q) + off; }
        const int nig = WGM * nN, gid = wgid / nig, fm = gid * WGM, gsz = (nM - fm) < WGM ? (nM - fm) : WGM;
        u.pm = fm + ((wgid % nig) % gsz); u.pn = (wgid % nig) / gsz; u.z = 0; return true;
    }
};
struct DualOrder {
    StaticOrder S;
    __device__ bool next(int i, Unit& u) const { const bool ok = S.next(i >> 1, u); u.z = i & 1; return ok; }
};

template <int ACT  > struct EpiBf16 {
    static constexpr bool HAS_MID = false;
    bf16_t* O; int ldc;
    __device__ __forceinline__ void operator()(const f32x4 (&acc)[2][2][4][2], const Unit& u, int wr, int wc, int fr, int fq) const {
        const int row0 = u.pm * BM + wr * 64 + fr, col0 = u.pn * BM + wc * 32 + 8 * fq;
#pragma unroll
        for (int ai = 0; ai < 2; ++ai)
#pragma unroll
            for (int m = 0; m < 4; ++m) { bf16_t* rowp = O + (size_t)(row0 + ai * HALF + m * 16) * ldc + col0;
#pragma unroll
                for (int bj = 0; bj < 2; ++bj) { f32x4 v0 = acc[ai][bj][m][0], v1 = acc[ai][bj][m][1];
                    if (ACT == 1) {
#pragma unroll
                        for (int j = 0; j < 4; ++j) { const float a = fmaxf(v0[j], 0.f), b = fmaxf(v1[j], 0.f); v0[j] = a * a; v1[j] = b * b; } }
                    u32x4 w; w.x = cvtpk(v0[0], v0[1]); w.y = cvtpk(v0[2], v0[3]); w.z = cvtpk(v1[0], v1[1]); w.w = cvtpk(v1[2], v1[3]);
                    *(u32x4*)(rowp + bj * HALF) = w; } }
    }
};
struct EpiIn {
    static constexpr bool HAS_MID = false;
    bf16_t* O; const float* bias; const float* rope;
    __device__ __forceinline__ void operator()(const f32x4 (&acc)[2][2][4][2], const Unit& u, int wr, int wc, int fr, int fq) const {
        const int row0 = u.pm * BM + wr * 64 + fr, col0 = u.pn * BM + wc * 32 + 8 * fq;
        const int mode = u.pn < 4 ? 1 : (u.pn >= 12 ? 2 : 0);
        f32x4 bv[2][2];
#pragma unroll
        for (int bj = 0; bj < 2; ++bj)
#pragma unroll
            for (int n = 0; n < 2; ++n) bv[bj][n] = (mode == 2) ? *(const f32x4*)(bias + (col0 - 3072) + bj * HALF + 4 * n) : (f32x4){0.f, 0.f, 0.f, 0.f};
#pragma unroll
        for (int ai = 0; ai < 2; ++ai)
#pragma unroll
            for (int m = 0; m < 4; ++m) { const int row = row0 + ai * HALF + m * 16; bf16_t* rowp = O + (size_t)row * NIN + col0; const int pos = row & (SEQ - 1);
#pragma unroll
                for (int bj = 0; bj < 2; ++bj) { f32x4 v0 = acc[ai][bj][m][0], v1 = acc[ai][bj][m][1];
                    if (mode == 1) {
                        const int i0 = ((col0 + bj * HALF) & 63) >> 1;
                        const f32x4 cs = *(const f32x4*)(rope + pos * 32 + i0), sn = *(const f32x4*)(rope + SEQ * 32 + pos * 32 + i0);
                        f32x4 a, b;
                        a[0] = v0[0] * cs[0] - v0[1] * sn[0]; a[1] = v0[1] * cs[0] + v0[0] * sn[0];
                        a[2] = v0[2] * cs[1] - v0[3] * sn[1]; a[3] = v0[3] * cs[1] + v0[2] * sn[1];
                        b[0] = v1[0] * cs[2] - v1[1] * sn[2]; b[1] = v1[1] * cs[2] + v1[0] * sn[2];
                        b[2] = v1[2] * cs[3] - v1[3] * sn[3]; b[3] = v1[3] * cs[3] + v1[2] * sn[3];
                        v0 = a; v1 = b;
                    } else if (mode == 2) {
                        v0 = v0 + bv[bj][0]; v1 = v1 + bv[bj][1];
#pragma unroll
                        for (int j = 0; j < 4; ++j) { v0[j] = 1.f / (1.f + __expf(-v0[j])); v1[j] = 1.f / (1.f + __expf(-v1[j])); }
                    }
                    u32x4 w; w.x = cvtpk(v0[0], v0[1]); w.y = cvtpk(v0[2], v0[3]); w.z = cvtpk(v1[0], v1[1]); w.w = cvtpk(v1[2], v1[3]);
                    *(u32x4*)(rowp + bj * HALF) = w; } }
    }
};
struct EpiUp {
    static constexpr bool HAS_MID = true;
    bf16_t* O; const bf16_t* proj;
    __device__ __forceinline__ void mid(f32x4 (&acc)[2][2][4][2], const Unit& u, int wr, int wc, int fr, int fq) const {
        const int row0 = u.pm * BM + wr * 64 + fr, col0 = u.pn * BM + wc * 32 + 8 * fq;
        const bf16_t* gp = proj + (size_t)row0 * NIN + 3072 + col0; asm volatile("" : "+v"(gp));
#pragma unroll
        for (int ai = 0; ai < 2; ++ai)
#pragma unroll
            for (int m = 0; m < 4; ++m) {
#pragma unroll
                for (int bj = 0; bj < 2; ++bj) { const bf16_t* gq = gp + (size_t)(ai * HALF + m * 16) * NIN + bj * HALF;
                    const u32x4 gm = *(const u32x4*)(gq);
                    const u32x4 gs = *(const u32x4*)(gq + 1024);
                    f32x4& v0 = acc[ai][bj][m][0]; f32x4& v1 = acc[ai][bj][m][1];
#define RT(a, b) ((a) * __builtin_amdgcn_rcpf(fmaxf((b), 1e-30f)))
                    v0[0] *= RT(bf_lo(gm.x), bf_lo(gs.x)); v0[1] *= RT(bf_hi(gm.x), bf_hi(gs.x)); v0[2] *= RT(bf_lo(gm.y), bf_lo(gs.y)); v0[3] *= RT(bf_hi(gm.y), bf_hi(gs.y));
                    v1[0] *= RT(bf_lo(gm.z), bf_lo(gs.z)); v1[1] *= RT(bf_hi(gm.z), bf_hi(gs.z)); v1[2] *= RT(bf_lo(gm.w), bf_lo(gs.w)); v1[3] *= RT(bf_hi(gm.w), bf_hi(gs.w));
#undef RT
                }
                asm volatile("" ::: "memory"); }
    }
    __device__ __forceinline__ void operator()(const f32x4 (&acc)[2][2][4][2], const Unit& u, int wr, int wc, int fr, int fq) const {
        const int row0 = u.pm * BM + wr * 64 + fr, col0 = u.pn * BM + wc * 32 + 8 * fq;
#pragma unroll
        for (int ai = 0; ai < 2; ++ai)
#pragma unroll
            for (int m = 0; m < 4; ++m) { const int row = row0 + ai * HALF + m * 16;
#pragma unroll
                for (int bj = 0; bj < 2; ++bj) { const int col = col0 + bj * HALF;
                    const u32x4 gw = *(const u32x4*)(proj + (size_t)row * NIN + 4096 + col);
                    f32x4 v0 = acc[ai][bj][m][0], v1 = acc[ai][bj][m][1];
                    v0[0] *= bf_lo(gw.x); v0[1] *= bf_hi(gw.x); v0[2] *= bf_lo(gw.y); v0[3] *= bf_hi(gw.y);
                    v1[0] *= bf_lo(gw.z); v1[1] *= bf_hi(gw.z); v1[2] *= bf_lo(gw.w); v1[3] *= bf_hi(gw.w);
                    u32x4 w; w.x = cvtpk(v0[0], v0[1]); w.y = cvtpk(v0[2], v0[3]); w.z = cvtpk(v1[0], v1[1]); w.w = cvtpk(v1[2], v1[3]);
                    *(u32x4*)(O + (size_t)row * D + col) = w; } }
    }
};

template <class Epi, class Sched, bool ALIGN_EPI>
__device__ __forceinline__ void gemm_phase(LAS unsigned char* lds, const Gemm g, const Sched& S, const Epi& E) {
    const int tid = threadIdx.x, wid = __builtin_amdgcn_readfirstlane(tid >> 6), lane = tid & 63, wr = wid >> 2, wc = wid & 3, fr = lane & 15, fq = lane >> 4;
    const int K = g.K, nt = K / BK;
    unsigned voffA[2], voffB[2];
#pragma unroll
    for (int i = 0; i < 2; ++i) { int R, C; stage_rc(tid * 16 + i * 8192, R, C); const int Rb = (R & ~31) + perm32(R & 31);
        voffA[i] = (unsigned)(R * g.lda + C) * 2u; voffB[i] = (unsigned)(Rb * g.ldb + C) * 2u; }
    const size_t kstep = (size_t)(BK * 2);
    const size_t hstepA = (size_t)HALF * g.lda * 2, hstepB = (size_t)HALF * g.ldb * 2;
    const size_t tstepA = 2 * hstepA, tstepB = 2 * hstepB;
    const unsigned ldsw = (unsigned)wid * 1024u;
    const int aoff = lds_byte(wr * 64 + fr, fq * 8), boff = lds_byte(wc * 32 + fr, fq * 8);
#define PG8_SA(b, h) (((b) * 2 + (h)) * HTB)
#define PG8_SB(b, h) ((4 + (b) * 2 + (h)) * HTB)
#define PG8_STAGE(bufoff, gbase, voff) do { _Pragma("unroll") for (int _i = 0; _i < 2; ++_i) \
        __builtin_amdgcn_global_load_lds((const unsigned*)((const char*)(gbase) + (voff)[_i]), (LAS unsigned*)(lds + (bufoff) + ldsw + _i * 8192), 16, 0, 0); } while (0)
#define PG8_LDA(dst, b, h) do { _Pragma("unroll") for (int m = 0; m < 4; ++m) _Pragma("unroll") for (int k = 0; k < 2; ++k) dst[m][k] = *(const LAS bf16x8*)(lds + PG8_SA(b, h) + aoff + m * 2048 + k * 1024); } while (0)
#define PG8_LDB(dst, b, h) do { _Pragma("unroll") for (int n = 0; n < 2; ++n) _Pragma("unroll") for (int k = 0; k < 2; ++k) dst[n][k] = *(const LAS bf16x8*)(lds + PG8_SB(b, h) + boff + n * 2048 + k * 1024); } while (0)
#define PG8_MMA(ai, bj, At, Bt) do { __builtin_amdgcn_s_setprio(1); _Pragma("unroll") for (int m = 0; m < 4; ++m) _Pragma("unroll") for (int n = 0; n < 2; ++n) _Pragma("unroll") for (int k = 0; k < 2; ++k) \
        acc[ai][bj][m][n] = __builtin_amdgcn_mfma_f32_16x16x32_bf16(Bt[n][k], At[m][k], acc[ai][bj][m][n], 0, 0, 0); __builtin_amdgcn_s_setprio(0); } while (0)
#define PG8_WAIT_V(n) asm volatile("s_waitcnt vmcnt(" #n ")" ::: "memory")
#define PG8_WAIT_L(n) asm volatile("s_waitcnt lgkmcnt(" #n ")" ::: "memory")
#define PG8_BAR __builtin_amdgcn_s_barrier()
#define PG8_SCHED __builtin_amdgcn_sched_barrier(0)
    Unit cur, nxt; int ui = 0;
    if (!S.next(0, cur)) return;
    f32x4 acc[2][2][4][2];
#pragma unroll
    for (int a = 0; a < 2; ++a)
#pragma unroll
        for (int b = 0; b < 2; ++b)
#pragma unroll
            for (int m = 0; m < 4; ++m)
#pragma unroll
                for (int n = 0; n < 2; ++n) acc[a][b][m][n] = (f32x4){0.f, 0.f, 0.f, 0.f};
    bf16x8 At[4][2], B0[2][2], B1[2][2];
    const char* cA = (const char*)g.A + (size_t)cur.pm * tstepA + (size_t)cur.z * g.zA; const char* cB = (const char*)g.Bt + (size_t)cur.pn * tstepB + (size_t)cur.z * g.zB;
    PG8_STAGE(PG8_SB(0, 0), cB, voffB); PG8_STAGE(PG8_SB(0, 1), cB + hstepB, voffB); PG8_STAGE(PG8_SA(0, 0), cA, voffA); PG8_STAGE(PG8_SA(0, 1), cA + hstepA, voffA);
    if (wr == 1) PG8_BAR;
    PG8_WAIT_V(2); PG8_BAR;
    PG8_STAGE(PG8_SB(1, 0), cB + kstep, voffB); PG8_STAGE(PG8_SA(1, 0), cA + kstep, voffA); PG8_STAGE(PG8_SB(1, 1), cB + hstepB + kstep, voffB);
    PG8_WAIT_V(6); PG8_BAR;
    for (;;) {
        const bool has_next = S.next(ui + 1, nxt);
        const char* nA = has_next ? (const char*)g.A + (size_t)nxt.pm * tstepA + (size_t)nxt.z * g.zA : cA; const char* nB = has_next ? (const char*)g.Bt + (size_t)nxt.pn * tstepB + (size_t)nxt.z * g.zB : cB;
        for (int t = 0; t < nt; t += 2) {
            if constexpr (Epi::HAS_MID) { if (t == (nt >> 1)) E.mid(acc, cur, wr, wc, fr, fq); }
            const bool last = (t == nt - 2);
            const char* a1 = cA + (size_t)(t + 1) * kstep;
            const char* a2 = last ? nA : cA + (size_t)(t + 2) * kstep; const char* b2 = last ? nB : cB + (size_t)(t + 2) * kstep;
            const char* a3 = a2 + kstep; const char* b3 = b2 + kstep;
            PG8_LDB(B0, 0, 0); PG8_LDB(B1, 0, 1); PG8_SCHED; PG8_LDA(At, 0, 0); PG8_STAGE(PG8_SA(1, 1), a1 + hstepA, voffA);
            PG8_WAIT_V(8); PG8_WAIT_L(0); PG8_BAR; PG8_MMA(0, 0, At, B0); PG8_MMA(0, 1, At, B1); PG8_BAR; PG8_SCHED;
            PG8_LDA(At, 0, 1); PG8_STAGE(PG8_SB(0, 0), b2, voffB); PG8_STAGE(PG8_SB(0, 1), b2 + hstepB, voffB); PG8_STAGE(PG8_SA(0, 0), a2, voffA);
            PG8_WAIT_V(8); PG8_WAIT_L(0); PG8_BAR; PG8_MMA(1, 0, At, B0); PG8_MMA(1, 1, At, B1); PG8_BAR; PG8_SCHED;
            PG8_LDB(B0, 1, 0); PG8_LDB(B1, 1, 1); PG8_SCHED; PG8_LDA(At, 1, 0); PG8_STAGE(PG8_SA(0, 1), a2 + hstepA, voffA);
            PG8_WAIT_V(8); PG8_WAIT_L(0); PG8_BAR; PG8_MMA(0, 0, At, B0); PG8_MMA(0, 1, At, B1); PG8_BAR; PG8_SCHED;
            PG8_LDA(At, 1, 1); PG8_STAGE(PG8_SB(1, 0), b3, voffB); PG8_STAGE(PG8_SB(1, 1), b3 + hstepB, voffB); PG8_STAGE(PG8_SA(1, 0), a3, voffA);
            PG8_WAIT_V(8); PG8_WAIT_L(0); PG8_BAR; PG8_MMA(1, 0, At, B0); PG8_MMA(1, 1, At, B1); PG8_BAR; PG8_SCHED;
        }
        if constexpr (ALIGN_EPI) { if (wr == 0) PG8_BAR; }
        E(acc, cur, wr, wc, fr, fq);
        if (!has_next) break;
#pragma unroll
        for (int a = 0; a < 2; ++a)
#pragma unroll
            for (int b = 0; b < 2; ++b)
#pragma unroll
                for (int m = 0; m < 4; ++m)
#pragma unroll
                    for (int n = 0; n < 2; ++n) acc[a][b][m][n] = (f32x4){0.f, 0.f, 0.f, 0.f};
        cur = nxt; cA = nA; cB = nB; ++ui;
        if constexpr (ALIGN_EPI) { if (wr == 1) PG8_BAR; }
    }
    PG8_WAIT_V(0);
    if constexpr (!ALIGN_EPI) { if (wr == 0) PG8_BAR; }
    PG8_BAR;
#undef PG8_SA
#undef PG8_SB
#undef PG8_STAGE
#undef PG8_LDA
#undef PG8_LDB
#undef PG8_MMA
#undef PG8_WAIT_V
#undef PG8_WAIT_L
#undef PG8_BAR
#undef PG8_SCHED
}
}

namespace att {
__device__ __forceinline__ int crow(int r, int hi) { return (r & 3) + 8 * (r >> 2) + 4 * hi; }
struct KVRegs { u32x4 k, v; };
__device__ __forceinline__ void kv_load(KVRegs& r, const bf16_t* Kp, const bf16_t* Vp, int tile, int tid) {
    const int row = tile * 64 + (tid >> 3), ch = tid & 7;
    r.k = *(const u32x4*)(Kp + (size_t)row * NIN + ch * 8);
    r.v = *(const u32x4*)(Vp + (size_t)row * NIN + ch * 8);
}
__device__ __forceinline__ void kv_store(const KVRegs& r, LAS unsigned char* kbuf, LAS unsigned char* vbuf, int tid) {
    const int row = tid >> 3, ch = tid & 7;
    *(LAS u32x4*)(kbuf + ch * 1024 + row * 16) = r.k;
    *(LAS u32x4*)(vbuf + ((ch >> 2) * 4 + (row >> 4)) * 1024 + (row & 15) * 64 + (ch & 3) * 16) = r.v;
}
__device__ __forceinline__ void qkt(f32x16& p0, f32x16& p1, LAS const unsigned char* kbuf, const bf16x8* qr, int r32, int hi) {
    LAS const unsigned char* kb = kbuf + hi * 1024 + r32 * 16;
    p0 = f32x16{}; p1 = f32x16{};
#pragma unroll
    for (int d0 = 0; d0 < 4; ++d0) {
        const bf16x8 b0 = *(LAS const bf16x8*)(kb + d0 * 2048);
        const bf16x8 b1 = *(LAS const bf16x8*)(kb + d0 * 2048 + 512);
        p0 = __builtin_amdgcn_mfma_f32_32x32x16_bf16(b0, qr[d0], p0, 0, 0, 0);
        p1 = __builtin_amdgcn_mfma_f32_32x32x16_bf16(b1, qr[d0], p1, 0, 0, 0);
    }
}
typedef short v4i16_t __attribute__((ext_vector_type(4)));
__device__ __forceinline__ s16x4 vtr(LAS const unsigned char* p) { return __builtin_bit_cast(s16x4, __builtin_amdgcn_ds_read_tr16_b64_v4i16((LAS v4i16_t*)p)); }
__device__ __forceinline__ void pv(f32x16* o, LAS const unsigned char* vbuf, const f32x16& p0, const f32x16& p1, int lane, int hi) {
    LAS const unsigned char* vp = vbuf + ((lane >> 4) & 1) * 32 + (lane & 3) * 8 + (4 * hi + ((lane & 15) >> 2)) * 64;
    u32x4 pw[4];
    pw[0] = (u32x4){cvtpk(p0[0], p0[1]), cvtpk(p0[2], p0[3]), cvtpk(p0[4], p0[5]), cvtpk(p0[6], p0[7])};
    pw[1] = (u32x4){cvtpk(p0[8], p0[9]), cvtpk(p0[10], p0[11]), cvtpk(p0[12], p0[13]), cvtpk(p0[14], p0[15])};
    pw[2] = (u32x4){cvtpk(p1[0], p1[1]), cvtpk(p1[2], p1[3]), cvtpk(p1[4], p1[5]), cvtpk(p1[6], p1[7])};
    pw[3] = (u32x4){cvtpk(p1[8], p1[9]), cvtpk(p1[10], p1[11]), cvtpk(p1[12], p1[13]), cvtpk(p1[14], p1[15])};
#pragma unroll
    for (int d0 = 0; d0 < 2; ++d0)
#pragma unroll
        for (int ks = 0; ks < 4; ++ks) {
            const s16x4 lo = vtr(vp + d0 * 4096 + ks * 1024), hh = vtr(vp + d0 * 4096 + ks * 1024 + 512);
            const bf16x8 vf = (bf16x8){lo[0], lo[1], lo[2], lo[3], hh[0], hh[1], hh[2], hh[3]};
            o[d0] = __builtin_amdgcn_mfma_f32_32x32x16_bf16(__builtin_bit_cast(bf16x8, pw[ks]), vf, o[d0], 0, 0, 0);
        }
}
constexpr int LDS_KV = 0, LDS_WS = 32768;

__device__ __forceinline__ void moba_unit(int b, int h, int qb, const bf16_t* proj, const float* kmean, bf16_t* Y, LAS unsigned char* lds) {
    const int tid = threadIdx.x, lane = tid & 63, r32 = lane & 31, hi = lane >> 5; const int wid = __builtin_amdgcn_readfirstlane(tid >> 6);
    const size_t rowbase = (size_t)b * SEQ; const int q0 = qb * 256, qrel = wid * 32 + r32;
    const bf16_t* Qrow = proj + (rowbase + q0 + qrel) * NIN + h * 64;
    const bf16_t* Kp = proj + rowbase * NIN + 512 + h * 64; const bf16_t* Vp = proj + rowbase * NIN + 1024 + h * 64;
    LAS float* wsf = (LAS float*)(lds + LDS_WS) + wid * 32;
    bf16x8 qr[4];
#pragma unroll
    for (int d0 = 0; d0 < 4; ++d0) qr[d0] = *(const bf16x8*)(Qrow + d0 * 16 + hi * 8);
    unsigned sel = 0;
    if (qb > 0) {
        float qf[32];
#pragma unroll
        for (int c = 0; c < 4; ++c) { const u32x4 w = *(const u32x4*)(Qrow + hi * 32 + c * 8);
            qf[c * 8 + 0] = bf_lo(w.x); qf[c * 8 + 1] = bf_hi(w.x); qf[c * 8 + 2] = bf_lo(w.y); qf[c * 8 + 3] = bf_hi(w.y);
            qf[c * 8 + 4] = bf_lo(w.z); qf[c * 8 + 5] = bf_hi(w.z); qf[c * 8 + 6] = bf_lo(w.w); qf[c * 8 + 7] = bf_hi(w.w); }
        float g[7];
#pragma unroll
        for (int n = 0; n < 7; ++n) { g[n] = -INFINITY;
            if (n < qb) { const float* km = kmean + ((size_t)(b * 8 + n) * 512 + h * 64 + 32 * hi); float s = 0.f;
#pragma unroll
                for (int j = 0; j < 32; j += 4) { const f32x4 kv = *(const f32x4*)(km + j); s += qf[j] * kv[0] + qf[j + 1] * kv[1] + qf[j + 2] * kv[2] + qf[j + 3] * kv[3]; }
                s += __shfl_xor(s, 32); g[n] = s; } }
#pragma unroll
        for (int n = 0; n < 7; ++n) { int cnt = 0;
#pragma unroll
            for (int n2 = 0; n2 < 7; ++n2) if (n2 != n) cnt += (g[n2] > g[n] || (g[n2] == g[n] && n2 < n)) ? 1 : 0;
            if (n < qb && cnt < 3) sel |= 1u << n; }
    }
    const int NT = 4 * qb + 4;
    KVRegs kv; kv_load(kv, Kp, Vp, 4 * qb, tid);
    float mrow = -INFINITY, lsum = 0.f; f32x16 o[2]; o[0] = f32x16{}; o[1] = f32x16{};
    for (int idx = 0; idx < NT; ++idx) {
        LAS unsigned char* kbuf = lds + LDS_KV + (idx & 1) * 16384; LAS unsigned char* vbuf = kbuf + 8192;
        kv_store(kv, kbuf, vbuf, tid);
        __syncthreads();
        if (idx + 1 < NT) kv_load(kv, Kp, Vp, (idx + 1 < 4) ? 4 * qb + idx + 1 : idx + 1 - 4, tid);
        const int kt = idx < 4 ? 4 * qb + idx : idx - 4;
        const bool mysel = idx < 4 ? true : (((sel >> (kt >> 2)) & 1u) != 0u);
        const bool active = idx < 4 ? (64 * idx <= 32 * wid + 31) : (__any(mysel ? 1 : 0) != 0);
        if (active) {
            f32x16 p0, p1; qkt(p0, p1, kbuf, qr, r32, hi);
            if (idx < 4) { const int kb = 64 * idx + 4 * hi;
#pragma unroll
                for (int r = 0; r < 16; ++r) { const int kvp = kb + (r & 3) + 8 * (r >> 2); if (kvp > qrel) p0[r] = -INFINITY; if (kvp + 32 > qrel) p1[r] = -INFINITY; } }
            else if (!mysel) {
#pragma unroll
                for (int r = 0; r < 16; ++r) { p0[r] = -INFINITY; p1[r] = -INFINITY; } }
            float rm = fmaxf(p0[0], p1[0]);
#pragma unroll
            for (int r = 1; r < 16; ++r) rm = fmaxf(rm, fmaxf(p0[r], p1[r]));
            rm = fmaxf(rm, __shfl_xor(rm, 32));
            const float mn = fmaxf(mrow, rm);
            if (__any(mn > mrow ? 1 : 0)) {
                const float f = __builtin_amdgcn_exp2f(mrow - mn);
                lsum *= f;
                if (hi == 0) wsf[r32] = f;
                asm volatile("s_waitcnt lgkmcnt(0)" ::: "memory");
#pragma unroll
                for (int r = 0; r < 16; ++r) { const float fr_ = wsf[crow(r, hi)]; o[0][r] *= fr_; o[1][r] *= fr_; }
                asm volatile("s_waitcnt lgkmcnt(0)" ::: "memory");
            }
            mrow = mn;
            float s = 0.f;
#pragma unroll
            for (int r = 0; r < 16; ++r) { p0[r] = __builtin_amdgcn_exp2f(p0[r] - mn); p1[r] = __builtin_amdgcn_exp2f(p1[r] - mn); s += p0[r] + p1[r]; }
            lsum += s;
            pv(o, vbuf, p0, p1, lane, hi);
        }
    }
    lsum += __shfl_xor(lsum, 32);
    if (hi == 0) wsf[r32] = 1.f / lsum;
    asm volatile("s_waitcnt lgkmcnt(0)" ::: "memory");
    bf16_t* Yw = Y + (rowbase + q0 + wid * 32) * D + h * 64 + r32;
#pragma unroll
    for (int r = 0; r < 16; ++r) { const int orow = crow(r, hi); const float il = wsf[orow];
        const unsigned w0 = cvtpk(o[0][r] * il, o[1][r] * il);
        Yw[(size_t)orow * D] = (bf16_t)(w0 & 0xffffu); Yw[(size_t)orow * D + 32] = (bf16_t)(w0 >> 16); }
    __syncthreads();
}

__device__ __forceinline__ void sb_unit(int b, int h, int qb, const bf16_t* proj, bf16_t* Y, LAS unsigned char* lds) {
    const int tid = threadIdx.x, lane = tid & 63, r32 = lane & 31, hi = lane >> 5; const int wid = __builtin_amdgcn_readfirstlane(tid >> 6);
    const size_t rowbase = (size_t)b * SEQ; const int w0 = qb * 256 + wid * 32, qpos = w0 + r32;
    const bf16_t* Qrow = proj + (rowbase + qpos) * NIN + 1536 + h * 64;
    const bf16_t* Kp = proj + rowbase * NIN + 2048 + h * 64; const bf16_t* Vp = proj + rowbase * NIN + 2560 + h * 64;
    bf16x8 qr[4];
#pragma unroll
    for (int d0 = 0; d0 < 4; ++d0) qr[d0] = *(const bf16x8*)(Qrow + d0 * 16 + hi * 8);
    float carry = 0.f; f32x16 o[2]; o[0] = f32x16{}; o[1] = f32x16{};
    int t = 4 * qb + 3, it = 0; bool wdone = false;
    KVRegs kv; kv_load(kv, Kp, Vp, t, tid);
    for (;;) {
        LAS unsigned char* kbuf = lds + LDS_KV + (it & 1) * 16384; LAS unsigned char* vbuf = kbuf + 8192;
        kv_store(kv, kbuf, vbuf, tid);
        if (__syncthreads_and(wdone ? 1 : 0)) break;
        if (t > 0) kv_load(kv, Kp, Vp, t - 1, tid);
        if (!wdone && 64 * t < w0 + 31) {
            f32x16 z0, z1; qkt(z0, z1, kbuf, qr, r32, hi);
            f32x16 L0, L1;
            const int kb = 64 * t + 4 * hi;
#pragma unroll
            for (int r = 0; r < 16; ++r) { const int key = kb + (r & 3) + 8 * (r >> 2);
                { const float z = z0[r]; const float sp = fmaxf(z, 0.f) + __builtin_amdgcn_logf(1.f + __builtin_amdgcn_exp2f(-fabsf(z))); const bool v = key < qpos; L0[r] = v ? -sp : 0.f; z0[r] = v ? z - sp : -INFINITY; }
                { const float z = z1[r]; const float sp = fmaxf(z, 0.f) + __builtin_amdgcn_logf(1.f + __builtin_amdgcn_exp2f(-fabsf(z))); const bool v = key + 32 < qpos; L1[r] = v ? -sp : 0.f; z1[r] = v ? z - sp : -INFINITY; } }
            float gs[8], tot[8];
#pragma unroll
            for (int g = 0; g < 4; ++g) { gs[g] = (L0[4 * g] + L0[4 * g + 1]) + (L0[4 * g + 2] + L0[4 * g + 3]); gs[4 + g] = (L1[4 * g] + L1[4 * g + 1]) + (L1[4 * g + 2] + L1[4 * g + 3]); }
#pragma unroll
            for (int g = 0; g < 8; ++g) tot[g] = gs[g] + __shfl_xor(gs[g], 32);
            float run = carry;
#pragma unroll
            for (int g = 7; g >= 0; --g) {
                const float e = run + (hi == 0 ? (tot[g] - gs[g]) : 0.f);
                run += tot[g];
                if (g >= 4) { const int q4 = 4 * (g - 4); const float l3 = L1[q4 + 3], l2 = L1[q4 + 2], l1 = L1[q4 + 1];
                    z1[q4 + 3] = __builtin_amdgcn_exp2f(z1[q4 + 3] + e); z1[q4 + 2] = __builtin_amdgcn_exp2f(z1[q4 + 2] + (e + l3));
                    z1[q4 + 1] = __builtin_amdgcn_exp2f(z1[q4 + 1] + (e + l3 + l2)); z1[q4] = __builtin_amdgcn_exp2f(z1[q4] + (e + l3 + l2 + l1)); }
                else { const int q4 = 4 * g; const float l3 = L0[q4 + 3], l2 = L0[q4 + 2], l1 = L0[q4 + 1];
                    z0[q4 + 3] = __builtin_amdgcn_exp2f(z0[q4 + 3] + e); z0[q4 + 2] = __builtin_amdgcn_exp2f(z0[q4 + 2] + (e + l3));
                    z0[q4 + 1] = __builtin_amdgcn_exp2f(z0[q4 + 1] + (e + l3 + l2)); z0[q4] = __builtin_amdgcn_exp2f(z0[q4] + (e + l3 + l2 + l1)); }
            }
            carry = run;
            pv(o, vbuf, z0, z1, lane, hi);
            wdone = __all(carry < -150.f ? 1 : 0) != 0;
        }
        if (t == 0) break;
        --t; ++it;
    }
    bf16_t* Yw = Y + (rowbase + w0) * D + 512 + h * 64 + r32;
#pragma unroll
    for (int r = 0; r < 16; ++r) { const int orow = crow(r, hi);
        const unsigned wv = cvtpk(o[0][r], o[1][r]);
        Yw[(size_t)orow * D] = (bf16_t)(wv & 0xffffu); Yw[(size_t)orow * D + 32] = (bf16_t)(wv >> 16); }
    __syncthreads();
}
}

__device__ __forceinline__ float wave_sum(float v) {
#pragma unroll
    for (int o = 1; o < 64; o <<= 1) v += __shfl_xor(v, o);
    return v;
}
__device__ __forceinline__ void transpose_item(const float* W, int K, int N, bf16_t* WT, int ldw, int mode, LAS float* scr, int item, int lane) {
    const int nblk = N / 32, kb = item / nblk, nb = item % nblk, k0 = 64 * kb, n0 = 32 * nb;
#pragma unroll 8
    for (int i = 0; i < 32; ++i) { const int kk = 2 * i + (lane >> 5); scr[kk * 33 + (lane & 31)] = W[(size_t)(k0 + kk) * N + n0 + (lane & 31)]; }
    asm volatile("s_waitcnt lgkmcnt(0)" ::: "memory");
    const int c = lane & 7;
#pragma unroll
    for (int j = 0; j < 4; ++j) { const int n = (lane >> 3) + 8 * j; const int ng = n0 + n; int drow = ng; float sc = 1.f;
        if (mode == 1) { if (ng < 1024) { const int l = ng & 63; drow = (ng & ~63) | ((l & 31) << 1) | (l >> 5); } if (ng < 512 || (ng >= 1536 && ng < 2048)) sc = QS; }
        const LAS float* s = scr + (8 * c) * 33 + n;
        u32x4 o; o.x = cvtpk(s[0 * 33] * sc, s[1 * 33] * sc); o.y = cvtpk(s[2 * 33] * sc, s[3 * 33] * sc); o.z = cvtpk(s[4 * 33] * sc, s[5 * 33] * sc); o.w = cvtpk(s[6 * 33] * sc, s[7 * 33] * sc);
        *(u32x4*)(WT + (size_t)drow * ldw + k0 + 8 * c) = o; }
    asm volatile("s_waitcnt lgkmcnt(0)" ::: "memory");
}
__device__ __forceinline__ void rms_row_to_bf16(const float* xrow, const float* g, bf16_t* orow, int lane) {
    const f32x4* xr = (const f32x4*)xrow + lane; const f32x4* gr = (const f32x4*)g + lane;
    f32x4 v[4]; float s = 0.f;
#pragma unroll
    for (int j = 0; j < 4; ++j) { v[j] = xr[64 * j]; s += (v[j].x * v[j].x + v[j].y * v[j].y) + (v[j].z * v[j].z + v[j].w * v[j].w); }
    const float rs = 1.f / sqrtf(wave_sum(s) * (1.f / D) + EPS);
    u32x2* o8 = (u32x2*)orow + lane;
#pragma unroll
    for (int j = 0; j < 4; ++j) { const f32x4 gg = gr[64 * j]; u32x2 w; w.x = cvtpk(v[j].x * rs * gg.x, v[j].y * rs * gg.y); w.y = cvtpk(v[j].z * rs * gg.z, v[j].w * rs * gg.w); o8[64 * j] = w; }
}

struct Args { const float* in[12]; float* out; unsigned char* ws; };

__global__ void __launch_bounds__(512, 2) fwd(Args a) {
    extern __shared__ __attribute__((aligned(16))) unsigned char lds_raw[];
    LAS unsigned char* lds = (LAS unsigned char*)lds_raw;
    cg::grid_group grid = cg::this_grid();
    const int tid = threadIdx.x, lane = tid & 63, wave = __builtin_amdgcn_readfirstlane(tid >> 6);
    const int G = gridDim.x, bx = blockIdx.x;
    const float* x = a.in[0]; const float* g_pre_mix = a.in[1]; const float* w_in = a.in[2]; const float* b_gate = a.in[3];
    const float* w_up_moba = a.in[4]; const float* w_up_sb = a.in[5]; const float* w_out = a.in[6]; const float* g_post_mix = a.in[7];
    const float* g_pre_mlp = a.in[8]; const float* w_mlp_in = a.in[9]; const float* w_mlp_out = a.in[10]; const float* g_post_mlp = a.in[11];
    unsigned char* ws = a.ws; float* out = a.out;
    float* rope = (float*)(ws + WS_ROPE); float* kmean = (float*)(ws + WS_KMEAN);
    bf16_t* Wt_in = (bf16_t*)(ws + WS_WIN); bf16_t* Wt_up = (bf16_t*)(ws + WS_WUP); bf16_t* Wt_out = (bf16_t*)(ws + WS_WOUT);
    bf16_t* Wt_mi = (bf16_t*)(ws + WS_WMI); bf16_t* Wt_mo = (bf16_t*)(ws + WS_WMO);
    bf16_t* XN = (bf16_t*)(ws + WS_XN); bf16_t* Y = (bf16_t*)(ws + WS_Y); bf16_t* proj = (bf16_t*)(ws + WS_PROJ); bf16_t* HB = (bf16_t*)(ws + WS_PROJ);
    const int gw = bx * 8 + wave, NGW = G * 8;

    {
        LAS float* scr = (LAS float*)(lds + wave * 16384);
        constexpr int I_IN = (D / 64) * (NIN / 32), I_UP = (512 / 64) * (D / 32), I_OUT = (D / 64) * (D / 32), I_MI = (D / 64) * (FF / 32), I_MO = (FF / 64) * (D / 32);
        constexpr int NITEMS = I_IN + 2 * I_UP + I_OUT + I_MI + I_MO;
        for (int it = gw; it < NITEMS; it += NGW) {
            int r = it;
            if (r < I_IN) { transpose_item(w_in, D, NIN, Wt_in, D, 1, scr, r, lane); continue; } r -= I_IN;
            if (r < I_UP) { transpose_item(w_up_moba, 512, D, Wt_up, D, 0, scr, r, lane); continue; } r -= I_UP;
            if (r < I_UP) { transpose_item(w_up_sb, 512, D, Wt_up + 512, D, 0, scr, r, lane); continue; } r -= I_UP;
            if (r < I_OUT) { transpose_item(w_out, D, D, Wt_out, D, 0, scr, r, lane); continue; } r -= I_OUT;
            if (r < I_MI) { transpose_item(w_mlp_in, D, FF, Wt_mi, D, 0, scr, r, lane); continue; } r -= I_MI;
            transpose_item(w_mlp_out, FF, D, Wt_mo, FF, 0, scr, r, lane);
        }
        for (int i = bx * 512 + tid; i < SEQ * 32; i += G * 512) { const int pos = i >> 5, fi = i & 31;
            const float inv = powf(10000.0f, -(float)fi * 2.0f / 64.0f); const float ang = (float)pos * inv;
            rope[i] = cosf(ang); rope[SEQ * 32 + i] = sinf(ang); }
        for (int m = gw; m < M; m += NGW) rms_row_to_bf16(x + (size_t)m * D, g_pre_mix, XN + (size_t)m * D, lane);
    }
    grid.sync();

    {
        pg8::Gemm g{XN, Wt_in, D, D, D, 0, 0}; pg8::StaticOrder S; S.init(M, NIN, G, bx);
        pg8::EpiIn E{proj, b_gate, rope};
        pg8::gemm_phase<pg8::EpiIn, pg8::StaticOrder, true>(lds, g, S, E);
    }
    grid.sync();

    for (int u = bx; u < NBATCH * 8; u += G) {
        const int cp = tid & 255, half = tid >> 8;
        const bf16_t* src = proj + ((size_t)u * 256 + half * 128) * NIN + 512 + cp * 2;
        float s0 = 0.f, s1 = 0.f;
#pragma unroll 8
        for (int r = 0; r < 128; ++r) { const unsigned w = *(const unsigned*)(src + (size_t)r * NIN); s0 += bf_lo(w); s1 += bf_hi(w); }
        LAS float* red = (LAS float*)lds;
        if (half == 1) { red[cp * 2] = s0; red[cp * 2 + 1] = s1; }
        __syncthreads();
        if (half == 0) { kmean[(size_t)u * 512 + cp * 2] = (s0 + red[cp * 2]) * (1.f / 256.f); kmean[(size_t)u * 512 + cp * 2 + 1] = (s1 + red[cp * 2 + 1]) * (1.f / 256.f); }
        __syncthreads();
    }
    grid.sync();

    for (int bh = bx; bh < NBATCH * 8; bh += G) {
        const int b = bh >> 3, h = bh & 7;
        for (int qb = 7; qb >= 0; --qb) att::moba_unit(b, h, qb, proj, kmean, Y, lds);
        for (int qb = 7; qb >= 0; --qb) att::sb_unit(b, h, qb, proj, Y, lds);
    }
    grid.sync();

    {
        pg8::Gemm g{Y, Wt_up, D, D, D, 0, 0}; pg8::StaticOrder S; S.init(M, D, G, bx);
        pg8::EpiUp E{XN, proj};
        pg8::gemm_phase<pg8::EpiUp, pg8::StaticOrder, true>(lds, g, S, E);
    }
    grid.sync();

    {
        pg8::Gemm g{XN, Wt_out, D, D, D, 0, 0}; pg8::StaticOrder S; S.init(M, D, G, bx);
        pg8::EpiBf16<0> E{Y, D};
        pg8::gemm_phase<pg8::EpiBf16<0>, pg8::StaticOrder, true>(lds, g, S, E);
    }
    grid.sync();

    for (int m = gw; m < M; m += NGW) {
        const f32x4* xr = (const f32x4*)(x + (size_t)m * D) + lane; const u32x2* mr = (const u32x2*)(Y + (size_t)m * D) + lane;
        f32x4 v[4], xv[4]; float s = 0.f;
#pragma unroll
        for (int j = 0; j < 4; ++j) { const u32x2 w = mr[64 * j]; v[j] = (f32x4){bf_lo(w.x), bf_hi(w.x), bf_lo(w.y), bf_hi(w.y)}; xv[j] = xr[64 * j];
            s += (v[j].x * v[j].x + v[j].y * v[j].y) + (v[j].z * v[j].z + v[j].w * v[j].w); }
        const float rs = 1.f / sqrtf(wave_sum(s) * (1.f / D) + EPS);
        float s2 = 0.f; f32x4* orow = (f32x4*)(out + (size_t)m * D) + lane;
#pragma unroll
        for (int j = 0; j < 4; ++j) { const f32x4 gg = ((const f32x4*)g_post_mix)[lane + 64 * j]; xv[j] = xv[j] + v[j] * rs * gg; orow[64 * j] = xv[j];
            s2 += (xv[j].x * xv[j].x + xv[j].y * xv[j].y) + (xv[j].z * xv[j].z + xv[j].w * xv[j].w); }
        const float rs2 = 1.f / sqrtf(wave_sum(s2) * (1.f / D) + EPS);
        u32x2* o8 = (u32x2*)(XN + (size_t)m * D) + lane;
#pragma unroll
        for (int j = 0; j < 4; ++j) { const f32x4 gg = ((const f32x4*)g_pre_mlp)[lane + 64 * j]; u32x2 w; w.x = cvtpk(xv[j].x * rs2 * gg.x, xv[j].y * rs2 * gg.y); w.y = cvtpk(xv[j].z * rs2 * gg.z, xv[j].w * rs2 * gg.w); o8[64 * j] = w; }
    }
    grid.sync();

    {
        pg8::Gemm g{XN, Wt_mi, D, D, D, 0, 0}; pg8::StaticOrder S; S.init(M, FF, G, bx);
        pg8::EpiBf16<1> E{HB, FF};
        pg8::gemm_phase<pg8::EpiBf16<1>, pg8::StaticOrder, true>(lds, g, S, E);
    }
    grid.sync();

    {
        pg8::Gemm g{HB, Wt_mo, FF, FF, FF, 0, 0}; pg8::StaticOrder S; S.init(M, D, G, bx);
        pg8::EpiBf16<0> E{Y, D};
        pg8::gemm_phase<pg8::EpiBf16<0>, pg8::StaticOrder, true>(lds, g, S, E);
    }
    grid.sync();

    for (int m = gw; m < M; m += NGW) {
        const u32x2* mr = (const u32x2*)(Y + (size_t)m * D) + lane; f32x4* orow = (f32x4*)(out + (size_t)m * D) + lane;
        f32x4 v[4], xv[4]; float s = 0.f;
#pragma unroll
        for (int j = 0; j < 4; ++j) { const u32x2 w = mr[64 * j]; v[j] = (f32x4){bf_lo(w.x), bf_hi(w.x), bf_lo(w.y), bf_hi(w.y)}; xv[j] = orow[64 * j];
            s += (v[j].x * v[j].x + v[j].y * v[j].y) + (v[j].z * v[j].z + v[j].w * v[j].w); }
        const float rs = 1.f / sqrtf(wave_sum(s) * (1.f / D) + EPS);
#pragma unroll
        for (int j = 0; j < 4; ++j) { const f32x4 gg = ((const f32x4*)g_post_mlp)[lane + 64 * j]; orow[64 * j] = xv[j] + v[j] * rs * gg; }
    }
}

extern "C" void kernel_launch(void* const* d_in, const int* in_sizes, int n_in, void* d_out, int out_size, void* d_ws, size_t ws_size, hipStream_t stream) {
    static int grid = 0;
    if (grid == 0) {
        if (n_in != 12 || in_sizes[0] != M * D || out_size != M * D || ws_size < WS_END) { fprintf(stderr, "kernel_launch: unexpected shapes (n_in %d, ws %zu)\n", n_in, ws_size); grid = -1; return; }
        int dev = 0, cus = 0, per_cu = 0;
        (void)hipGetDevice(&dev); (void)hipDeviceGetAttribute(&cus, hipDeviceAttributeMultiprocessorCount, dev);
        (void)hipFuncSetAttribute((const void*)fwd, hipFuncAttributeMaxDynamicSharedMemorySize, LDS_BYTES);
        (void)hipOccupancyMaxActiveBlocksPerMultiprocessor(&per_cu, (const void*)fwd, 512, LDS_BYTES);
        if (per_cu < 1) { fprintf(stderr, "kernel_launch: occupancy query says %d blocks per CU\n", per_cu); per_cu = 1; }
        (void)hipGetLastError();
        grid = cus;
    }
    if (grid < 0) return;
    Args a{};
    for (int i = 0; i < 12; ++i) a.in[i] = (const float*)d_in[i];
    a.out = (float*)d_out; a.ws = (unsigned char*)d_ws;
    void* args[] = {&a};
    hipError_t e = hipLaunchCooperativeKernel((const void*)fwd, dim3(grid), dim3(512), args, LDS_BYTES, stream);
    if (e != hipSuccess) fprintf(stderr, "cooperative launch failed: %s (grid %d)\n", hipGetErrorString(e), grid);
}
```
